# Optimizing an MI355X kernel written in HIP

```python
import math
import jax, jax.numpy as jnp
from jax import lax
import numpy as np

D_MODEL = 1024
BATCH = 4
SEQ = 8192
DEPTH = 4
DEC_BATCH = 8
DEC_SEQ = 16
PAST_LEN = 2048

CHUNK = 64
N_META = 16
N_MIXERS = 2
N_A = (DEPTH + 1) // 2
N_B = DEPTH // 2
N_HEADS = 8
HEAD_DIM = D_MODEL // N_HEADS
HD = N_HEADS * HEAD_DIM
IDX_HEADS = 8
IDX_DIM = 64
TOPK_MAX = 256
N_BUCKETS = 32
MAX_DISTANCE = 128
D_FF = 2816
CONV_W = 3
Q_BLOCK = 128
ALPHA = (2 * DEPTH) ** 0.25
BETA = (8 * DEPTH) ** -0.25
LN_EPS = 1e-5
IDX_Q_OFF = 3 * HD
IDX_K_OFF = IDX_Q_OFF + IDX_HEADS * IDX_DIM
IDX_W_OFF = IDX_K_OFF + IDX_DIM
A_IN = IDX_W_OFF + IDX_HEADS
B_IN = 3 * HD

kernel_name = 'dsa_stickbreak_convffn_stream'


def layer_norm(x, g, b):
    xf = x.astype(jnp.float32)
    mu = jnp.mean(xf, -1, keepdims=True)
    var = jnp.mean(jnp.square(xf - mu), -1, keepdims=True)
    y = (xf - mu) * lax.rsqrt(var + LN_EPS) * g.astype(jnp.float32) + b.astype(jnp.float32)
    return y.astype(x.dtype)


def rel_bucket(rel):
    nb = N_BUCKETS // 2
    max_exact = nb // 2
    ret = jnp.where(rel > 0, nb, 0)
    n = jnp.abs(rel)
    nf = jnp.maximum(n, 1).astype(jnp.float32)
    large = max_exact + (jnp.log(nf / max_exact) / math.log(MAX_DISTANCE / max_exact)
                         * (nb - max_exact)).astype(jnp.int32)
    large = jnp.minimum(large, nb - 1)
    return ret + jnp.where(n < max_exact, n, large)


def chunk_id(pos, n_lead):
    return jnp.where(pos < n_lead, -1, (pos - n_lead) // CHUNK)


def map_query_blocks(fn, batched, vectors):
    b, t = batched[0].shape[:2]
    n_blk = -(-t // Q_BLOCK)
    pad = n_blk * Q_BLOCK - t
    def split_b(a):
        a = jnp.pad(a, [(0, 0), (0, pad)] + [(0, 0)] * (a.ndim - 2))
        return jnp.swapaxes(a.reshape((b, n_blk, Q_BLOCK) + a.shape[2:]), 0, 1)
    def split_v(a):
        return jnp.pad(a, (0, pad), mode='edge').reshape(n_blk, Q_BLOCK)
    blocks = tuple(split_b(a) for a in batched) + tuple(split_v(a) for a in vectors)
    out = lax.map(lambda blk: fn(*blk), blocks)
    out = jnp.swapaxes(out, 0, 1)
    return out.reshape((b, n_blk * Q_BLOCK) + out.shape[3:])[:, :t]


def dsa_attend(q, qi, wi, k, v, ki, q_pos, k_pos, q_chunk, k_chunk, rel_bias, topk):
    s = jnp.einsum('bqhd,bld->bqhl', qi, ki).astype(jnp.float32)
    score = jnp.einsum('bqhl,bqh->bql', jax.nn.relu(s), wi.astype(jnp.float32))
    visible = k_chunk[None, :] <= q_chunk[:, None]
    score = jnp.where(visible[None], score, -jnp.inf)
    _, idx = lax.top_k(score, topk)
    gather = jax.vmap(lambda a, i: a[i])
    k_sel = gather(k, idx)
    v_sel = gather(v, idx)
    logits = jnp.einsum('bqhd,bqkhd->bhqk', q, k_sel).astype(jnp.float32) * (HEAD_DIM ** -0.5)
    rel = k_pos[idx] - q_pos[None, :, None]
    bias = rel_bias.astype(jnp.float32)[rel_bucket(rel)]
    logits = logits + jnp.transpose(bias, (0, 3, 1, 2))
    valid = k_chunk[idx] <= q_chunk[None, :, None]
    logits = jnp.where(valid[:, None], logits, -jnp.inf)
    p = jax.nn.softmax(logits, axis=-1).astype(v.dtype)
    return jnp.einsum('bhqk,bqkhd->bqhd', p, v_sel)


def stick_breaking(q, k, v, q_pos, k_pos):
    z = jnp.einsum('bqhd,blhd->bhql', q, k).astype(jnp.float32) * (HEAD_DIM ** -0.5)
    causal = (k_pos[None, :] < q_pos[:, None])[None, None]
    log_1m = jnp.where(causal, jax.nn.log_sigmoid(-z), 0.0)
    between = lax.cumsum(log_1m, axis=3, reverse=True) - log_1m
    a = jnp.where(causal, jnp.exp(jax.nn.log_sigmoid(z) + between), 0.0)
    return jnp.einsum('bhql,blhd->bqhd', a.astype(v.dtype), v)


def project_a(x, w_in):
    b, t, _ = x.shape
    h = x @ w_in
    q = h[..., :HD].reshape(b, t, N_HEADS, HEAD_DIM)
    k = h[..., HD:2 * HD].reshape(b, t, N_HEADS, HEAD_DIM)
    v = h[..., 2 * HD:3 * HD].reshape(b, t, N_HEADS, HEAD_DIM)
    qi = h[..., IDX_Q_OFF:IDX_K_OFF].reshape(b, t, IDX_HEADS, IDX_DIM)
    ki = h[..., IDX_K_OFF:IDX_W_OFF]
    wi = h[..., IDX_W_OFF:] * ((IDX_HEADS * IDX_DIM) ** -0.5)
    return q, k, v, qi, ki, wi


def project_b(x, w_in):
    b, t, _ = x.shape
    h = (x @ w_in).reshape(b, t, 3, N_HEADS, HEAD_DIM)
    return h[:, :, 0], h[:, :, 1], h[:, :, 2]


def mixer_a_prompt(x, w_in, w_out, rel_bias, topk):
    b, t, _ = x.shape
    q, k, v, qi, ki, wi = project_a(x, w_in)
    pos = jnp.arange(t, dtype=jnp.int32)
    chunk = chunk_id(pos, N_META)
    fn = lambda qb, qib, wib, pb, cb: dsa_attend(qb, qib, wib, k, v, ki, pb, pos, cb, chunk, rel_bias, topk)
    o = map_query_blocks(fn, (q, qi, wi), (pos, chunk))
    return o.reshape(b, t, HD) @ w_out, k, v, ki


def mixer_a_sample(x, ck, cv, cki, w_in, w_out, rel_bias, topk):
    b, t, _ = x.shape
    p = ck.shape[1]
    q, k, v, qi, ki, wi = project_a(x, w_in)
    k_all = jnp.concatenate([ck.astype(k.dtype), k], axis=1)
    v_all = jnp.concatenate([cv.astype(v.dtype), v], axis=1)
    ki_all = jnp.concatenate([cki.astype(ki.dtype), ki], axis=1)
    k_pos = jnp.arange(p + t, dtype=jnp.int32)
    q_pos = p + jnp.arange(t, dtype=jnp.int32)
    o = dsa_attend(q, qi, wi, k_all, v_all, ki_all, q_pos, k_pos,
                   chunk_id(q_pos, 0), chunk_id(k_pos, 0), rel_bias, topk)
    return o.reshape(b, t, HD) @ w_out, k, v, ki


def mixer_b_prompt(x, w_in, w_out):
    b, t, _ = x.shape
    q, k, v = project_b(x, w_in)
    pos = jnp.arange(t, dtype=jnp.int32)
    fn = lambda qb, pb: stick_breaking(qb, k, v, pb, pos)
    o = map_query_blocks(fn, (q,), (pos,))
    return o.reshape(b, t, HD) @ w_out, k, v


def mixer_b_sample(x, ck, cv, w_in, w_out):
    b, t, _ = x.shape
    p = ck.shape[1]
    q, k, v = project_b(x, w_in)
    k_all = jnp.concatenate([ck.astype(k.dtype), k], axis=1)
    v_all = jnp.concatenate([cv.astype(v.dtype), v], axis=1)
    k_pos = jnp.arange(p + t, dtype=jnp.int32)
    q_pos = p + jnp.arange(t, dtype=jnp.int32)
    o = stick_breaking(q, k_all, v_all, q_pos, k_pos)
    return o.reshape(b, t, HD) @ w_out, k, v


def conv_ffn(x, left, w_gate, w_up, conv_w, conv_b, w_down):
    t = x.shape[1]
    g = x @ w_gate
    u = x @ w_up
    gp = jnp.concatenate([left.astype(g.dtype), g], axis=1)
    gc = conv_b + conv_w[0] * gp[:, 0:t]
    for i in range(1, CONV_W):
        gc = gc + conv_w[i] * gp[:, i:i + t]
    h = jax.nn.gelu(gc) * u
    return h @ w_down, gp[:, gp.shape[1] - (CONV_W - 1):]


def setup_inputs(seed: int = 0) -> dict:
    key = jax.random.key(seed)
    ks = jax.random.split(key, 24)
    def nrm(k, shape, scale=1.0):
        return jax.random.normal(k, shape, jnp.float32) * scale
    return {
        'x_prompt': nrm(ks[0], (BATCH, SEQ, D_MODEL)),
        'x_sample': nrm(ks[1], (DEC_BATCH, DEC_SEQ, D_MODEL)),
        'cache_a_k': nrm(ks[2], (N_A, DEC_BATCH, PAST_LEN, N_HEADS, HEAD_DIM)),
        'cache_a_v': nrm(ks[3], (N_A, DEC_BATCH, PAST_LEN, N_HEADS, HEAD_DIM)),
        'cache_a_idx_k': nrm(ks[4], (N_A, DEC_BATCH, PAST_LEN, IDX_DIM)),
        'cache_b_k': nrm(ks[5], (N_B, DEC_BATCH, PAST_LEN, N_HEADS, HEAD_DIM)),
        'cache_b_v': nrm(ks[6], (N_B, DEC_BATCH, PAST_LEN, N_HEADS, HEAD_DIM)),
        'state_ffn_conv': nrm(ks[7], (DEPTH, DEC_BATCH, CONV_W - 1, D_FF)),
        'meta_tokens': nrm(ks[8], (N_META, D_MODEL)),
        'rel_bias': nrm(ks[9], (N_BUCKETS, N_HEADS), 0.5),
        'w_a_in': nrm(ks[10], (N_A, D_MODEL, A_IN), D_MODEL ** -0.5),
        'w_a_out': nrm(ks[11], (N_A, HD, D_MODEL), BETA * HD ** -0.5),
        'w_b_in': nrm(ks[12], (N_B, D_MODEL, B_IN), D_MODEL ** -0.5),
        'w_b_out': nrm(ks[13], (N_B, HD, D_MODEL), BETA * HD ** -0.5),
        'ln1_g': 1.0 + nrm(ks[14], (DEPTH, D_MODEL), 0.05),
        'ln1_b': nrm(ks[15], (DEPTH, D_MODEL), 0.02),
        'ln2_g': 1.0 + nrm(ks[16], (DEPTH, D_MODEL), 0.05),
        'ln2_b': nrm(ks[17], (DEPTH, D_MODEL), 0.02),
        'w_ffn_gate': nrm(ks[18], (DEPTH, D_MODEL, D_FF), D_MODEL ** -0.5),
        'w_ffn_up': nrm(ks[19], (DEPTH, D_MODEL, D_FF), D_MODEL ** -0.5),
        'ffn_conv_w': nrm(ks[20], (DEPTH, CONV_W, D_FF), CONV_W ** -0.5),
        'ffn_conv_b': nrm(ks[21], (DEPTH, D_FF), 0.02),
        'w_ffn_down': nrm(ks[22], (DEPTH, D_FF, D_MODEL), BETA * D_FF ** -0.5),
    }


def reference(x_prompt, x_sample, cache_a_k, cache_a_v, cache_a_idx_k, cache_b_k, cache_b_v,
              state_ffn_conv, meta_tokens, rel_bias, w_a_in, w_a_out, w_b_in, w_b_out,
              ln1_g, ln1_b, ln2_g, ln2_b, w_ffn_gate, w_ffn_up, ffn_conv_w, ffn_conv_b, w_ffn_down):
    b = x_prompt.shape[0]
    meta = jnp.broadcast_to(meta_tokens.astype(x_prompt.dtype)[None], (b, N_META, D_MODEL))
    xp = jnp.concatenate([meta, x_prompt], axis=1)
    xs = x_sample
    topk_p = min(TOPK_MAX, x_prompt.shape[1] // 4)
    topk_s = min(TOPK_MAX, (cache_a_k.shape[2] + x_sample.shape[1]) // 4)
    zero_left = jnp.zeros((b, CONV_W - 1, D_FF), xp.dtype)
    a_k_p, a_v_p, a_ik_p, a_k_s, a_v_s, a_ik_s = [], [], [], [], [], []
    b_k_p, b_v_p, b_k_s, b_v_s = [], [], [], []
    conv_p, conv_s = [], []
    for i in range(DEPTH):
        j = i // N_MIXERS
        if i % N_MIXERS == 0:
            mp, kp, vp, kip = mixer_a_prompt(xp, w_a_in[j], w_a_out[j], rel_bias, topk_p)
            ms, kn, vn, kin = mixer_a_sample(xs, cache_a_k[j], cache_a_v[j], cache_a_idx_k[j],
                                             w_a_in[j], w_a_out[j], rel_bias, topk_s)
            a_k_p.append(kp); a_v_p.append(vp); a_ik_p.append(kip)
            a_k_s.append(kn); a_v_s.append(vn); a_ik_s.append(kin)
        else:
            mp, kp, vp = mixer_b_prompt(xp, w_b_in[j], w_b_out[j])
            ms, kn, vn = mixer_b_sample(xs, cache_b_k[j], cache_b_v[j], w_b_in[j], w_b_out[j])
            b_k_p.append(kp); b_v_p.append(vp)
            b_k_s.append(kn); b_v_s.append(vn)
        xp = layer_norm(ALPHA * xp + mp, ln1_g[i], ln1_b[i])
        xs = layer_norm(ALPHA * xs + ms, ln1_g[i], ln1_b[i])
        fp, cp = conv_ffn(xp, zero_left, w_ffn_gate[i], w_ffn_up[i], ffn_conv_w[i], ffn_conv_b[i], w_ffn_down[i])
        fs, cs = conv_ffn(xs, state_ffn_conv[i], w_ffn_gate[i], w_ffn_up[i], ffn_conv_w[i], ffn_conv_b[i], w_ffn_down[i])
        conv_p.append(cp); conv_s.append(cs)
        xp = layer_norm(ALPHA * xp + fp, ln2_g[i], ln2_b[i])
        xs = layer_norm(ALPHA * xs + fs, ln2_g[i], ln2_b[i])
    y_prompt = xp[:, N_META:]
    return (y_prompt, xs,
            jnp.stack(a_k_p), jnp.stack(a_v_p), jnp.stack(a_ik_p),
            jnp.stack(b_k_p), jnp.stack(b_v_p), jnp.stack(conv_p),
            jnp.stack(a_k_s), jnp.stack(a_v_s), jnp.stack(a_ik_s),
            jnp.stack(b_k_s), jnp.stack(b_v_s), jnp.stack(conv_s))
```

```cpp
#include <hip/hip_runtime.h>
#include <hip/hip_cooperative_groups.h>
#include <cstdio>
namespace cg = cooperative_groups;
namespace pg8 {
#define PG8_LAS __attribute__((address_space(3)))
typedef unsigned short bf16_t;
typedef short bf16x8 __attribute__((ext_vector_type(8)));
typedef float f32x4 __attribute__((ext_vector_type(4)));
typedef unsigned u32x4 __attribute__((ext_vector_type(4)));
constexpr int BM = 256, BK = 64, HALF = 128, HTB = HALF * BK * 2  , STAGE_BYTES = 8 * HTB, NXCD = 8, WGM = 8;

__host__ __device__ __forceinline__ int lds_byte(int r, int c) { const int st = (r >> 4) * 2 + (c >> 5), rr = r & 15, cc = c & 31, ob = rr * 64 + cc * 2; return st * 1024 + (ob ^ (((ob >> 9) & 1) << 5)); }
__host__ __device__ __forceinline__ void stage_rc(int b, int& R, int& C) { const int st = b / 1024, sb = b % 1024, swz = sb ^ (((sb >> 9) & 1) << 5); R = (st >> 1) * 16 + swz / 64; C = (st & 1) * 32 + (swz % 64) / 2; }
__host__ __device__ __forceinline__ int perm32(int rho) { const int n = rho >> 4, i = rho & 15; return 8 * (i >> 2) + 4 * n + (i & 3); }

struct Unit { int pm, pn; };
struct Gemm { const bf16_t* A; const bf16_t* Bt; int M, N, K; };

struct StaticOrder {
    int nM, nN, nwg, G, c;
    __host__ __device__ void init(int M, int N, int G_, int c_) { nM = M / BM; nN = N / BM; nwg = nM * nN; G = G_; c = c_; }
    __host__ __device__ bool next(int i, Unit& u) const {
        const long L = (long)i * G + c; if (L >= nwg) return false;
        int wgid = (int)L; { const int q = nwg / NXCD, r = nwg % NXCD, xcd = wgid % NXCD, off = wgid / NXCD; wgid = (xcd < r ? xcd * (q + 1) : r * (q + 1) + (xcd - r) * q) + off; }
        const int nig = WGM * nN, gid = wgid / nig, fm = gid * WGM, gsz = (nM - fm) < WGM ? (nM - fm) : WGM;
        u.pm = fm + ((wgid % nig) % gsz); u.pn = (wgid % nig) / gsz; return true;
    }
    __device__ __forceinline__ void a_ready(const Unit&) const {}
    __device__ __forceinline__ void done(const Unit&) const {}
};
template <class Epi, class Sched, bool STAMP = false>
__device__ __forceinline__ void gemm_phase(PG8_LAS unsigned char* lds, const Gemm g, const Sched& S, const Epi& E, unsigned long long* stamps) {
    const int tid = threadIdx.x, wid = __builtin_amdgcn_readfirstlane(tid >> 6), lane = tid & 63, wr = wid >> 2, wc = wid & 3, fr = lane & 15, fq = lane >> 4;
    const int K = g.K, nt = K / BK;
    int ts_lo = 0, ts_hi = 0, nts = 0; const unsigned long long rt_entry = STAMP ? (unsigned long long)wall_clock64() : 0ull;
#define PG8_STAMP() do { if (STAMP && wid == 0 && nts < 64) { const unsigned long long _c = (unsigned long long)clock64(); \
        ts_lo = (lane == nts) ? (int)(unsigned)_c : ts_lo; ts_hi = (lane == nts) ? (int)(unsigned)(_c >> 32) : ts_hi; ++nts; } } while (0)
    PG8_STAMP();
    unsigned voffA[2], voffB[2];
#pragma unroll
    for (int i = 0; i < 2; ++i) { int R, C; stage_rc(tid * 16 + i * 8192, R, C); const int Rb = Epi::PERM ? ((R & ~31) + perm32(R & 31)) : R;
        voffA[i] = (unsigned)(R * K + C) * 2u; voffB[i] = (unsigned)(Rb * K + C) * 2u; }
    const size_t kstep = (size_t)(BK * 2);
    const size_t hstep = (size_t)HALF * K * 2;
    const size_t tstep = 2 * hstep;
    const unsigned ldsw = (unsigned)wid * 1024u;
    const int aoff = lds_byte(wr * 64 + fr, fq * 8), boff = lds_byte(wc * 32 + fr, fq * 8);
#define PG8_SA(b, h) (((b) * 2 + (h)) * HTB)
#define PG8_SB(b, h) ((4 + (b) * 2 + (h)) * HTB)
#define PG8_STAGE(bufoff, gbase, voff) do { _Pragma("unroll") for (int _i = 0; _i < 2; ++_i) \
        __builtin_amdgcn_global_load_lds((const unsigned*)((const char*)(gbase) + (voff)[_i]), (PG8_LAS unsigned*)(lds + (bufoff) + ldsw + _i * 8192), 16, 0, 0); } while (0)
#define PG8_LDA(dst, b, h) do { _Pragma("unroll") for (int m = 0; m < 4; ++m) _Pragma("unroll") for (int k = 0; k < 2; ++k) dst[m][k] = *(const PG8_LAS bf16x8*)(lds + PG8_SA(b, h) + aoff + m * 2048 + k * 1024); } while (0)
#define PG8_LDB(dst, b, h) do { _Pragma("unroll") for (int n = 0; n < 2; ++n) _Pragma("unroll") for (int k = 0; k < 2; ++k) dst[n][k] = *(const PG8_LAS bf16x8*)(lds + PG8_SB(b, h) + boff + n * 2048 + k * 1024); } while (0)
#define PG8_MMA(ai, bj, At, Bt) do { __builtin_amdgcn_s_setprio(1); _Pragma("unroll") for (int m = 0; m < 4; ++m) _Pragma("unroll") for (int n = 0; n < 2; ++n) _Pragma("unroll") for (int k = 0; k < 2; ++k) \
        acc[ai][bj][m][n] = __builtin_amdgcn_mfma_f32_16x16x32_bf16(Bt[n][k], At[m][k], acc[ai][bj][m][n], 0, 0, 0); __builtin_amdgcn_s_setprio(0); } while (0)
#define PG8_WAIT_V(n) asm volatile("s_waitcnt vmcnt(" #n ")" ::: "memory")
#define PG8_WAIT_L(n) asm volatile("s_waitcnt lgkmcnt(" #n ")" ::: "memory")
#define PG8_BAR __builtin_amdgcn_s_barrier()
#define PG8_SCHED __builtin_amdgcn_sched_barrier(0)
    Unit cur, nxt; int ui = 0;
    if (!S.next(0, cur)) return;
    f32x4 acc[2][2][4][2];
#pragma unroll
    for (int a = 0; a < 2; ++a)
#pragma unroll
        for (int b = 0; b < 2; ++b)
#pragma unroll
            for (int m = 0; m < 4; ++m)
#pragma unroll
                for (int n = 0; n < 2; ++n) acc[a][b][m][n] = (f32x4){0.f, 0.f, 0.f, 0.f};
    bf16x8 At[4][2], B0[2][2], B1[2][2];
    const char* cA = (const char*)g.A + (size_t)cur.pm * tstep; const char* cB = (const char*)g.Bt + (size_t)cur.pn * tstep;
    S.a_ready(cur);
    PG8_STAGE(PG8_SB(0, 0), cB, voffB); PG8_STAGE(PG8_SA(0, 0), cA, voffA); PG8_STAGE(PG8_SB(0, 1), cB + hstep, voffB); PG8_STAGE(PG8_SA(0, 1), cA + hstep, voffA);
    if (wr == 1) PG8_BAR;
    PG8_WAIT_V(4); PG8_BAR;
    PG8_STAGE(PG8_SB(1, 0), cB + kstep, voffB); PG8_STAGE(PG8_SA(1, 0), cA + kstep, voffA); PG8_STAGE(PG8_SB(1, 1), cB + hstep + kstep, voffB);
    PG8_WAIT_V(6); PG8_BAR;
    PG8_STAMP();
    for (;;) {
        const bool has_next = S.next(ui + 1, nxt);
        const char* nA = has_next ? (const char*)g.A + (size_t)nxt.pm * tstep : cA; const char* nB = has_next ? (const char*)g.Bt + (size_t)nxt.pn * tstep : cB;
        for (int t = 0; t < nt; t += 2) {
            const bool last = (t == nt - 2);
            const char* a1 = cA + (size_t)(t + 1) * kstep;
            const char* a2 = last ? nA : cA + (size_t)(t + 2) * kstep; const char* b2 = last ? nB : cB + (size_t)(t + 2) * kstep;
            const char* a3 = a2 + kstep; const char* b3 = b2 + kstep;
            if (last && has_next) S.a_ready(nxt);
            PG8_LDB(B0, 0, 0); PG8_SCHED; PG8_LDA(At, 0, 0); PG8_STAGE(PG8_SA(1, 1), a1 + hstep, voffA);
            PG8_WAIT_L(8); PG8_BAR; PG8_WAIT_L(0); PG8_MMA(0, 0, At, B0); PG8_BAR; PG8_SCHED;
            PG8_LDB(B1, 0, 1); PG8_STAGE(PG8_SB(0, 0), b2, voffB);
            PG8_BAR; PG8_WAIT_L(0); PG8_MMA(0, 1, At, B1); PG8_BAR;
            PG8_LDA(At, 0, 1); PG8_STAGE(PG8_SA(0, 0), a2, voffA);
            PG8_BAR; PG8_WAIT_L(0); PG8_MMA(1, 0, At, B0); PG8_BAR; PG8_SCHED;
            PG8_STAGE(PG8_SB(0, 1), b2 + hstep, voffB);
            PG8_WAIT_V(6); PG8_BAR; PG8_MMA(1, 1, At, B1); PG8_BAR;
            PG8_LDB(B0, 1, 0); PG8_SCHED; PG8_LDA(At, 1, 0); PG8_STAGE(PG8_SA(0, 1), a2 + hstep, voffA);
            PG8_WAIT_L(8); PG8_BAR; PG8_WAIT_L(0); PG8_MMA(0, 0, At, B0); PG8_BAR; PG8_SCHED;
            PG8_LDB(B1, 1, 1); PG8_STAGE(PG8_SB(1, 0), b3, voffB);
            PG8_BAR; PG8_WAIT_L(0); PG8_MMA(0, 1, At, B1); PG8_BAR;
            PG8_LDA(At, 1, 1); PG8_STAGE(PG8_SA(1, 0), a3, voffA);
            PG8_BAR; PG8_WAIT_L(0); PG8_MMA(1, 0, At, B0); PG8_BAR; PG8_SCHED;
            PG8_STAGE(PG8_SB(1, 1), b3 + hstep, voffB);
            PG8_WAIT_V(6); PG8_BAR; PG8_MMA(1, 1, At, B1); PG8_BAR;
        }
        PG8_STAMP();
        if constexpr (!Epi::AFTER_DRAIN) { E(acc, cur, wr, wc, fr, fq); S.done(cur); }
        PG8_STAMP();
        if (!has_next) break;
#pragma unroll
        for (int a = 0; a < 2; ++a)
#pragma unroll
            for (int b = 0; b < 2; ++b)
#pragma unroll
                for (int m = 0; m < 4; ++m)
#pragma unroll
                    for (int n = 0; n < 2; ++n) acc[a][b][m][n] = (f32x4){0.f, 0.f, 0.f, 0.f};
        cur = nxt; cA = nA; cB = nB; ++ui;
    }
    PG8_WAIT_V(0);
    if (wr == 0) PG8_BAR;
    PG8_BAR;
    if constexpr (Epi::AFTER_DRAIN) { E.fused(acc, cur, wr, wc, fr, fq, lds, wid, lane); S.done(cur); }
    PG8_STAMP();
    if (STAMP && wid == 0) { stamps[lane] = lane < nts ? (((unsigned long long)(unsigned)ts_hi << 32) | (unsigned)ts_lo) : 0ull;
        if (lane == 62) stamps[62] = rt_entry; if (lane == 63) stamps[63] = (unsigned long long)wall_clock64(); }
#undef PG8_STAMP
#undef PG8_SA
#undef PG8_SB
#undef PG8_STAGE
#undef PG8_LDA
#undef PG8_LDB
#undef PG8_MMA
#undef PG8_WAIT_V
#undef PG8_WAIT_L
#undef PG8_BAR
#undef PG8_SCHED
}
}
using pg8::bf16_t; using pg8::bf16x8; using pg8::f32x4; using pg8::u32x4;
typedef float f32x16 __attribute__((ext_vector_type(16)));
typedef float f32x2 __attribute__((ext_vector_type(2)));
typedef __bf16 bf2_t __attribute__((ext_vector_type(2)));
typedef unsigned u32x2 __attribute__((ext_vector_type(2)));
#define DI __device__ __forceinline__
#define LAS __attribute__((address_space(3)))
#define MFMA32(a, b, c) __builtin_amdgcn_mfma_f32_32x32x16_bf16((a), (b), (c), 0, 0, 0)

constexpr int D = 1024, NB = 4, SEQ = 8192, NMETA = 16, LP = NMETA + SEQ  , DB = 8, DSEQ = 16, PAST = 2048, LS = PAST + DSEQ  ;
constexpr int NH = 8, HDIM = 128, IDXD = 64, IH = 8, DFF = 2816, TOPK = 256;
constexpr int M_P = NB * LP  , M_S = DB * DSEQ  , M_ALL = M_P + M_S  , M_PAD = 33024;
constexpr int A_IN = 3656, A_IN_PAD = 3840, B_IN = 3072;
constexpr int LPP = 8256, LSP = 2112;
constexpr int KR_TOT = M_P + DB * LS  , KR_PAD = 49408;
constexpr int NKB_P = 258, NKB_S = 66;
constexpr float ALPHA = 1.6817928305074290f;
constexpr float QSCALE = 0.08838834764831845f;
constexpr float WISCALE = 0.04419417382415922f;
constexpr float LN_EPS = 1e-5f;

constexpr size_t O_YP = 0, O_YS = O_YP + (size_t)NB * SEQ * D, O_AKP = O_YS + (size_t)M_S * D, O_AVP = O_AKP + 2ull * M_P * D, O_AIKP = O_AVP + 2ull * M_P * D,
                 O_BKP = O_AIKP + 2ull * M_P * IDXD, O_BVP = O_BKP + 2ull * M_P * D, O_CONVP = O_BVP + 2ull * M_P * D, O_AKS = O_CONVP + 4ull * NB * 2 * DFF,
                 O_AVS = O_AKS + 2ull * M_S * D, O_AIKS = O_AVS + 2ull * M_S * D, O_BKS = O_AIKS + 2ull * M_S * IDXD, O_BVS = O_BKS + 2ull * M_S * D,
                 O_CONVS = O_BVS + 2ull * M_S * D, O_END = O_CONVS + 4ull * DB * 2 * DFF;

constexpr size_t al256(size_t x) { return (x + 255) & ~(size_t)255; }
constexpr size_t W_AIN = 0, W_AOUT = W_AIN + 2ull * A_IN_PAD * D * 2, W_BIN = W_AOUT + 2ull * D * D * 2, W_BOUT = W_BIN + 2ull * B_IN * D * 2,
                 W_FFN1 = W_BOUT + 2ull * D * D * 2, W_FFN2 = W_FFN1 + 4ull * 2 * DFF * D * 2, W_END = W_FFN2 + 4ull * D * DFF * 2;
constexpr size_t WS_X = al256(W_END), WS_XB = WS_X + (size_t)M_PAD * D * 4, WS_KS = WS_XB + (size_t)M_PAD * D * 2;
constexpr size_t WS_R1 = al256(WS_KS);
constexpr size_t R_QB = WS_R1, R_OB = R_QB + (size_t)M_PAD * D * 2, R_KB = R_OB + (size_t)M_PAD * D * 2, R_VT = R_KB + (size_t)KR_PAD * D * 2,
                 R_VTS = R_VT + (size_t)NB * NH * HDIM * LPP * 2, R_QIB = R_VTS + (size_t)DB * NH * HDIM * LSP * 2, R_KIB = R_QIB + (size_t)M_PAD * 512 * 2,
                 R_WIB = R_KIB + (size_t)KR_PAD * IDXD * 2, R_MASK = R_WIB + (size_t)M_PAD * 8 * 4,
                 MASK_S0 = (size_t)NB * NKB_P * LP * 2  , R_THR = al256(R_MASK + (MASK_S0 + (size_t)DB * NKB_S * DSEQ * 2) * 2 + 4096),
                 R_ATT_END = R_THR + (size_t)M_PAD * 4;
constexpr size_t R_G = WS_R1, R_U = R_G + (size_t)M_PAD * DFF * 2, R_H = R_U + (size_t)M_PAD * DFF * 2, R_FFN_END = R_H + (size_t)M_PAD * DFF * 2;
constexpr size_t WS_NEED = (R_ATT_END > R_FFN_END ? R_ATT_END : R_FFN_END);

constexpr int LDS_BYTES = 153600;

struct Params {
  const float* in[23];
  float* out;
  unsigned char* ws;
};
enum { I_XP = 0, I_XS, I_CAK, I_CAV, I_CAIK, I_CBK, I_CBV, I_CONV, I_META, I_RELB, I_WAIN, I_WAOUT, I_WBIN, I_WBOUT, I_LN1G, I_LN1B, I_LN2G, I_LN2B, I_WG, I_WU, I_CW, I_CB, I_WD };

DI unsigned pk2(float lo, float hi) { f32x2 v = {lo, hi}; return __builtin_bit_cast(unsigned, __builtin_convertvector(v, bf2_t)); }
DI bf16x8 pk8(float a0, float a1, float a2, float a3, float a4, float a5, float a6, float a7) {
  u32x4 p = {pk2(a0, a1), pk2(a2, a3), pk2(a4, a5), pk2(a6, a7)}; return __builtin_bit_cast(bf16x8, p); }
DI float bf2f(unsigned short b) { return __uint_as_float(((unsigned)b) << 16); }
DI int pi_row(int i) { return 16 * ((i >> 2) & 1) + 4 * (i >> 3) + (i & 3); }

DI int snake_item(int round, int b, int G) { return round * G + ((round & 1) ? (G - 1 - b) : b); }

struct Entry { int Tq, L, qrow0, krow0, qpos0, pitch; size_t vt_off  , mask_off; bool samp; };
DI Entry get_entry(int e) {
  Entry E;
  if (e < NB) { E.Tq = LP; E.L = LP; E.qrow0 = e * LP; E.krow0 = e * LP; E.qpos0 = 0; E.pitch = LPP; E.vt_off = (size_t)e * NH * HDIM * LPP; E.mask_off = (size_t)e * NKB_P * LP * 2; E.samp = false; }
  else { const int sb = e - NB; E.Tq = DSEQ; E.L = LS; E.qrow0 = M_P + sb * DSEQ; E.krow0 = M_P + sb * LS; E.qpos0 = PAST; E.pitch = LSP; E.vt_off = (size_t)sb * NH * HDIM * LSP; E.mask_off = MASK_S0 + (size_t)sb * NKB_S * DSEQ * 2; E.samp = true; }
  return E;
}
DI int vis_end(bool samp, int tq) { return samp ? LS : (tq < NMETA ? NMETA : NMETA + 64 * (((tq - NMETA) >> 6) + 1)); }
DI int rel_bucket(int rel) {
  const int n = rel < 0 ? -rel : rel; int b;
  if (n < 8) b = n; else if (n < 12) b = 8; else if (n < 16) b = 9; else if (n < 23) b = 10; else if (n < 32) b = 11; else if (n < 46) b = 12; else if (n < 64) b = 13; else if (n < 91) b = 14; else b = 15;
  return b + (rel > 0 ? 16 : 0);
}
DI void wjob(const Params& P, int job, const float*& src, int& K, int& N, bf16_t*& dst) {
  if (job < 2) { src = P.in[I_WAIN] + (size_t)job * D * A_IN; K = D; N = A_IN; dst = (bf16_t*)(P.ws + W_AIN) + (size_t)job * A_IN_PAD * D; }
  else if (job < 4) { const int j = job - 2; src = P.in[I_WAOUT] + (size_t)j * D * D; K = D; N = D; dst = (bf16_t*)(P.ws + W_AOUT) + (size_t)j * D * D; }
  else if (job < 6) { const int j = job - 4; src = P.in[I_WBIN] + (size_t)j * D * B_IN; K = D; N = B_IN; dst = (bf16_t*)(P.ws + W_BIN) + (size_t)j * B_IN * D; }
  else if (job < 8) { const int j = job - 6; src = P.in[I_WBOUT] + (size_t)j * D * D; K = D; N = D; dst = (bf16_t*)(P.ws + W_BOUT) + (size_t)j * D * D; }
  else if (job < 12) { const int l = job - 8; src = P.in[I_WG] + (size_t)l * D * DFF; K = D; N = DFF; dst = (bf16_t*)(P.ws + W_FFN1) + (size_t)l * 2 * DFF * D; }
  else if (job < 16) { const int l = job - 12; src = P.in[I_WU] + (size_t)l * D * DFF; K = D; N = DFF; dst = (bf16_t*)(P.ws + W_FFN1) + (size_t)l * 2 * DFF * D + (size_t)DFF * D; }
  else { const int l = job - 16; src = P.in[I_WD] + (size_t)l * DFF * D; K = DFF; N = D; dst = (bf16_t*)(P.ws + W_FFN2) + (size_t)l * D * DFF; }
}
DI void tr_tile(const float* src, size_t srcpitch, int nlim, bf16_t* dst, size_t dstpitch, float* tl  ) {
  const int tid = threadIdx.x;
#pragma unroll
  for (int i = 0; i < 8; ++i) { const int kk = (tid >> 6) + 8 * i, nn = tid & 63; tl[nn * 65 + kk] = nn < nlim ? src[(size_t)kk * srcpitch + nn] : 0.f; }
  __syncthreads();
#pragma unroll
  for (int i = 0; i < 4; ++i) { const int nn = (tid >> 5) + 16 * i, kk = 2 * (tid & 31); *(unsigned*)(dst + (size_t)nn * dstpitch + kk) = pk2(tl[nn * 65 + kk], tl[nn * 65 + kk + 1]); }
  __syncthreads();
}
DI void phase0(const Params& P, unsigned char* lds) {
  float* tl = (float*)lds;
  for (int job = 0; job < 20; ++job) {
    const float* src; int K, N; bf16_t* dst; wjob(P, job, src, K, N, dst);
    const int ntn = (N + 63) >> 6, nt = (K >> 6) * ntn;
    for (int t = blockIdx.x; t < nt; t += gridDim.x) { const int tk = t / ntn, tn = t - tk * ntn;
      tr_tile(src + (size_t)tk * 64 * N + tn * 64, N, N - tn * 64, dst + (size_t)tn * 64 * K + tk * 64, K, tl); }
  }
  float* X = (float*)(P.ws + WS_X); bf16_t* XB = (bf16_t*)(P.ws + WS_XB);
  const size_t nth = (size_t)gridDim.x * 512, gt = (size_t)blockIdx.x * 512 + threadIdx.x;
  for (size_t i = gt; i < (size_t)M_ALL * 256; i += nth) {
    const int row = (int)(i >> 8), c4 = (int)(i & 255); const float* s;
    if (row < M_P) { const int b = row / LP, t = row - b * LP; s = t < NMETA ? P.in[I_META] + (size_t)t * D : P.in[I_XP] + ((size_t)b * SEQ + (t - NMETA)) * D; }
    else s = P.in[I_XS] + (size_t)(row - M_P) * D;
    const f32x4 v = *(const f32x4*)(s + 4 * c4);
    *(f32x4*)(X + (size_t)row * D + 4 * c4) = v;
    u32x2 pk = {pk2(v[0], v[1]), pk2(v[2], v[3])}; *(u32x2*)(XB + (size_t)row * D + 4 * c4) = pk;
  }
}
DI void cache_phase(const Params& P, unsigned char* lds, bool isA, int j) {
  const float* ck = (isA ? P.in[I_CAK] : P.in[I_CBK]) + (size_t)j * DB * PAST * D;
  const float* cv = (isA ? P.in[I_CAV] : P.in[I_CBV]) + (size_t)j * DB * PAST * D;
  bf16_t* KB = (bf16_t*)(P.ws + R_KB); bf16_t* VTS = (bf16_t*)(P.ws + R_VTS); bf16_t* KIB = (bf16_t*)(P.ws + R_KIB);
  const size_t nth = (size_t)gridDim.x * 512, gt = (size_t)blockIdx.x * 512 + threadIdx.x;
  for (size_t i = gt; i < (size_t)DB * PAST * 256; i += nth) {
    const int c4 = (int)(i & 255); const int rp = (int)(i >> 8); const int sb = rp >> 11, pos = rp & 2047;
    const f32x4 v = *(const f32x4*)(ck + (size_t)rp * D + 4 * c4);
    u32x2 pk = {pk2(v[0], v[1]), pk2(v[2], v[3])}; *(u32x2*)(KB + (size_t)(M_P + sb * LS + pos) * D + 4 * c4) = pk;
  }
  if (isA) {
    const float* cik = P.in[I_CAIK] + (size_t)j * DB * PAST * IDXD;
    for (size_t i = gt; i < (size_t)DB * PAST * 16; i += nth) {
      const int c4 = (int)(i & 15); const int rp = (int)(i >> 4); const int sb = rp >> 11, pos = rp & 2047;
      const f32x4 v = *(const f32x4*)(cik + (size_t)rp * IDXD + 4 * c4);
      u32x2 pk = {pk2(v[0], v[1]), pk2(v[2], v[3])}; *(u32x2*)(KIB + (size_t)(M_P + sb * LS + pos) * IDXD + 4 * c4) = pk;
    }
  }
  float* tl = (float*)lds;
  for (int t = blockIdx.x; t < DB * NH * 32 * 2; t += gridDim.x) {
    const int dt = t & 1, pt = (t >> 1) & 31, head = (t >> 6) & 7, sb = t >> 9;
    tr_tile(cv + ((size_t)sb * PAST + pt * 64) * D + head * HDIM + dt * 64, D, 64, VTS + ((size_t)(sb * NH + head) * HDIM + dt * 64) * LSP + pt * 64, LSP, tl);
  }
}
struct EpiInProj {
  static constexpr bool PERM = false, AFTER_DRAIN = false;
  int isA, j; float* out; unsigned char* ws;
  __device__ __forceinline__ void operator()(const f32x4 (&acc)[2][2][4][2], const pg8::Unit& u, int wr, int wc, int fr, int fq) const {
    const int pn = u.pn; const int sec = pn >> 2;
    bf16_t* QB = (bf16_t*)(ws + R_QB); bf16_t* KB = (bf16_t*)(ws + R_KB); bf16_t* VT = (bf16_t*)(ws + R_VT); bf16_t* VTS = (bf16_t*)(ws + R_VTS);
    bf16_t* QIB = (bf16_t*)(ws + R_QIB); bf16_t* KIB = (bf16_t*)(ws + R_KIB); float* WIB = (float*)(ws + R_WIB);
#pragma unroll
    for (int ai = 0; ai < 2; ++ai)
#pragma unroll
      for (int m = 0; m < 4; ++m) {
        const int row = u.pm * 256 + ai * 128 + wr * 64 + m * 16 + fr;
        if (row >= M_ALL) continue;
        const bool samp = row >= M_P; const int srow = row - M_P;
        const int b = samp ? (srow >> 4) : row / LP; const int t = samp ? (srow & 15) : row - b * LP;
        const int krow = samp ? M_P + b * LS + PAST + t : row;
#pragma unroll
        for (int bj = 0; bj < 2; ++bj)
#pragma unroll
          for (int n = 0; n < 2; ++n) {
            const int col = pn * 256 + bj * 128 + wc * 32 + n * 16 + 4 * fq; const f32x4 v = acc[ai][bj][m][n];
            if (sec == 0) { u32x2 pk = {pk2(v[0] * QSCALE, v[1] * QSCALE), pk2(v[2] * QSCALE, v[3] * QSCALE)}; *(u32x2*)(QB + (size_t)row * D + col) = pk; }
            else if (sec == 1) { const int c = col - D;
              float* o = samp ? out + (isA ? O_AKS : O_BKS) + (size_t)j * M_S * D + (size_t)srow * D + c : out + (isA ? O_AKP : O_BKP) + (size_t)j * M_P * D + (size_t)row * D + c;
              *(f32x4*)o = v; u32x2 pk = {pk2(v[0], v[1]), pk2(v[2], v[3])}; *(u32x2*)(KB + (size_t)krow * D + c) = pk; }
            else if (sec == 2) { const int c = col - 2 * D;
              float* o = samp ? out + (isA ? O_AVS : O_BVS) + (size_t)j * M_S * D + (size_t)srow * D + c : out + (isA ? O_AVP : O_BVP) + (size_t)j * M_P * D + (size_t)row * D + c;
              *(f32x4*)o = v; const int head = c >> 7, d = c & 127;
              bf16_t* vt = samp ? VTS + ((size_t)(b * NH + head) * HDIM + d) * LSP + PAST + t : VT + ((size_t)(b * NH + head) * HDIM + d) * LPP + t;
              const int pitch = samp ? LSP : LPP; const unsigned p01 = pk2(v[0], v[1]), p23 = pk2(v[2], v[3]);
              vt[0] = (bf16_t)(p01 & 0xffff); vt[pitch] = (bf16_t)(p01 >> 16); vt[2 * pitch] = (bf16_t)(p23 & 0xffff); vt[3 * pitch] = (bf16_t)(p23 >> 16); }
            else { const int c = col - 3 * D;
              if (c < 512) { u32x2 pk = {pk2(v[0], v[1]), pk2(v[2], v[3])}; *(u32x2*)(QIB + (size_t)row * 512 + c) = pk; }
              else if (c < 576) { const int cc = c - 512;
                float* o = samp ? out + O_AIKS + (size_t)j * M_S * IDXD + (size_t)srow * IDXD + cc : out + O_AIKP + (size_t)j * M_P * IDXD + (size_t)row * IDXD + cc;
                *(f32x4*)o = v; u32x2 pk = {pk2(v[0], v[1]), pk2(v[2], v[3])}; *(u32x2*)(KIB + (size_t)krow * IDXD + cc) = pk; }
              else if (c < 584) { f32x4 wv = {v[0] * WISCALE, v[1] * WISCALE, v[2] * WISCALE, v[3] * WISCALE}; *(f32x4*)(WIB + (size_t)row * 8 + (c - 576)) = wv; }
            }
          }
      }
  }
};
struct EpiResid {
  static constexpr bool PERM = false, AFTER_DRAIN = false;
  float* X;
  __device__ __forceinline__ void operator()(const f32x4 (&acc)[2][2][4][2], const pg8::Unit& u, int wr, int wc, int fr, int fq) const {
#pragma unroll
    for (int ai = 0; ai < 2; ++ai)
#pragma unroll
      for (int m = 0; m < 4; ++m) {
        const int row = u.pm * 256 + ai * 128 + wr * 64 + m * 16 + fr;
        if (row >= M_ALL) continue;
#pragma unroll
        for (int bj = 0; bj < 2; ++bj)
#pragma unroll
          for (int n = 0; n < 2; ++n) {
            const int col = u.pn * 256 + bj * 128 + wc * 32 + n * 16 + 4 * fq;
            float* p = X + (size_t)row * D + col; const f32x4 x = *(const f32x4*)p; const f32x4 v = acc[ai][bj][m][n];
            f32x4 r = {ALPHA * x[0] + v[0], ALPHA * x[1] + v[1], ALPHA * x[2] + v[2], ALPHA * x[3] + v[3]}; *(f32x4*)p = r;
          }
      }
  }
};
struct EpiFFN1 {
  static constexpr bool PERM = false, AFTER_DRAIN = false;
  int l; float* out; unsigned char* ws;
  __device__ __forceinline__ void operator()(const f32x4 (&acc)[2][2][4][2], const pg8::Unit& u, int wr, int wc, int fr, int fq) const {
    const bool gate = u.pn < 11; bf16_t* dst = (bf16_t*)(ws + (gate ? R_G : R_U));
#pragma unroll
    for (int ai = 0; ai < 2; ++ai)
#pragma unroll
      for (int m = 0; m < 4; ++m) {
        const int row = u.pm * 256 + ai * 128 + wr * 64 + m * 16 + fr;
        if (row >= M_ALL) continue;
        float* cst = nullptr;
        if (gate) {
          if (row >= M_P) { const int srow = row - M_P, sb = srow >> 4, t = srow & 15; if (t >= DSEQ - 2) cst = out + O_CONVS + ((size_t)(l * DB + sb) * 2 + (t - (DSEQ - 2))) * DFF; }
          else { const int b = row / LP, t = row - b * LP; if (t >= LP - 2) cst = out + O_CONVP + ((size_t)(l * NB + b) * 2 + (t - (LP - 2))) * DFF; }
        }
#pragma unroll
        for (int bj = 0; bj < 2; ++bj)
#pragma unroll
          for (int n = 0; n < 2; ++n) {
            const int col = (gate ? u.pn : u.pn - 11) * 256 + bj * 128 + wc * 32 + n * 16 + 4 * fq; const f32x4 v = acc[ai][bj][m][n];
            u32x2 pk = {pk2(v[0], v[1]), pk2(v[2], v[3])}; *(u32x2*)(dst + (size_t)row * DFF + col) = pk;
            if (cst) *(f32x4*)(cst + col) = v;
          }
      }
  }
};
template <class Epi> DI void run_gemm(unsigned char* lds, const bf16_t* A, const bf16_t* Bt, int M, int N, int K, const Epi& E) {
  pg8::Gemm g{A, Bt, M, N, K}; pg8::StaticOrder S; S.init(M, N, (int)gridDim.x, (int)blockIdx.x);
  pg8::gemm_phase<Epi, pg8::StaticOrder, false>((LAS unsigned char*)lds, g, S, E, nullptr);
}
DI float wave_sum(float v) {
#pragma unroll
  for (int o = 32; o >= 1; o >>= 1) v += __shfl_xor(v, o);
  return v;
}
DI void ln_phase(const Params& P, const float* g, const float* be, bool fin) {
  float* X = (float*)(P.ws + WS_X); bf16_t* XB = (bf16_t*)(P.ws + WS_XB);
  const int lane = threadIdx.x & 63, w = threadIdx.x >> 6;
  f32x4 gv[4], bv[4];
#pragma unroll
  for (int i = 0; i < 4; ++i) { gv[i] = *(const f32x4*)(g + 4 * (i * 64 + lane)); bv[i] = *(const f32x4*)(be + 4 * (i * 64 + lane)); }
  for (int row = blockIdx.x * 8 + w; row < M_ALL; row += gridDim.x * 8) {
    float* xr = X + (size_t)row * D; f32x4 v[4]; float s = 0.f;
#pragma unroll
    for (int i = 0; i < 4; ++i) { v[i] = *(const f32x4*)(xr + 4 * (i * 64 + lane)); s += v[i][0] + v[i][1] + v[i][2] + v[i][3]; }
    const float mu = wave_sum(s) * (1.f / D); float q = 0.f;
#pragma unroll
    for (int i = 0; i < 4; ++i) { v[i] -= mu; q += v[i][0] * v[i][0] + v[i][1] * v[i][1] + v[i][2] * v[i][2] + v[i][3] * v[i][3]; }
    const float rstd = rsqrtf(wave_sum(q) * (1.f / D) + LN_EPS);
    float* yo = nullptr;
    if (fin) { if (row >= M_P) yo = P.out + O_YS + (size_t)(row - M_P) * D; else { const int b = row / LP, t = row - b * LP; if (t >= NMETA) yo = P.out + O_YP + ((size_t)b * SEQ + (t - NMETA)) * D; } }
#pragma unroll
    for (int i = 0; i < 4; ++i) { const f32x4 y = v[i] * rstd * gv[i] + bv[i]; const int c = 4 * (i * 64 + lane);
      *(f32x4*)(xr + c) = y; u32x2 pk = {pk2(y[0], y[1]), pk2(y[2], y[3])}; *(u32x2*)(XB + (size_t)row * D + c) = pk; if (yo) *(f32x4*)(yo + c) = y; }
  }
}
DI float gelu_tanh(float x) { const float y = 0.7978845608028654f * (x + 0.044715f * x * x * x); return x * __builtin_amdgcn_rcpf(1.f + __expf(-2.f * y)); }
DI void conv_phase(const Params& P, int l) {
  const bf16_t* G = (const bf16_t*)(P.ws + R_G); const bf16_t* U = (const bf16_t*)(P.ws + R_U); bf16_t* H = (bf16_t*)(P.ws + R_H);
  const float* cw = P.in[I_CW] + (size_t)l * 3 * DFF; const float* cb = P.in[I_CB] + (size_t)l * DFF; const float* st = P.in[I_CONV] + (size_t)l * DB * 2 * DFF;
  const size_t nth = (size_t)gridDim.x * 512, gt = (size_t)blockIdx.x * 512 + threadIdx.x;
  for (size_t i = gt; i < (size_t)M_ALL * 352; i += nth) {
    const int row = (int)(i / 352), ch = (int)(i - (size_t)row * 352), f0 = 8 * ch;
    int t, sb = 0; const bool samp = row >= M_P;
    if (samp) { const int srow = row - M_P; sb = srow >> 4; t = srow & 15; } else t = row % LP;
    const bf16x8 g0 = *(const bf16x8*)(G + (size_t)row * DFF + f0); const bf16x8 uu = *(const bf16x8*)(U + (size_t)row * DFF + f0);
    float p1[8], p2[8];
    if (t >= 1) { const bf16x8 a = *(const bf16x8*)(G + (size_t)(row - 1) * DFF + f0);
#pragma unroll
      for (int k = 0; k < 8; ++k) p1[k] = bf2f((unsigned short)a[k]); }
    else {
#pragma unroll
      for (int k = 0; k < 8; ++k) p1[k] = samp ? st[((size_t)sb * 2 + 1) * DFF + f0 + k] : 0.f; }
    if (t >= 2) { const bf16x8 a = *(const bf16x8*)(G + (size_t)(row - 2) * DFF + f0);
#pragma unroll
      for (int k = 0; k < 8; ++k) p2[k] = bf2f((unsigned short)a[k]); }
    else {
#pragma unroll
      for (int k = 0; k < 8; ++k) p2[k] = samp ? st[((size_t)sb * 2 + t) * DFF + f0 + k] : 0.f; }
    float hv[8];
#pragma unroll
    for (int k = 0; k < 8; ++k) { const float gc = cb[f0 + k] + cw[f0 + k] * p2[k] + cw[DFF + f0 + k] * p1[k] + cw[2 * DFF + f0 + k] * bf2f((unsigned short)g0[k]);
      hv[k] = gelu_tanh(gc) * bf2f((unsigned short)uu[k]); }
    *(bf16x8*)(H + (size_t)row * DFF + f0) = pk8(hv[0], hv[1], hv[2], hv[3], hv[4], hv[5], hv[6], hv[7]);
  }
}
DI void idx_scores(f32x16& sc, const bf16x8 (&qif)[4][4], const unsigned char* qlds  , const float (&wi)[8], const bf16_t* kp) {
  bf16x8 kf[4];
#pragma unroll
  for (int s = 0; s < 4; ++s) kf[s] = *(const bf16x8*)(kp + 16 * s);
#pragma unroll
  for (int r = 0; r < 16; ++r) sc[r] = 0.f;
#pragma unroll
  for (int hd = 0; hd < 8; ++hd) {
    asm volatile("" ::: "memory");
    f32x16 acc;
#pragma unroll
    for (int r = 0; r < 16; ++r) acc[r] = 0.f;
#pragma unroll
    for (int s = 0; s < 4; ++s) {
      bf16x8 qv; if (hd < 4) qv = qif[hd & 3][s]; else qv = *(const bf16x8*)(qlds + ((hd - 4) * 4 + s) * 1024);
      acc = MFMA32(kf[s], qv, acc);
    }
#pragma unroll
    for (int r = 0; r < 16; ++r) { const float t = fmaxf(acc[r], 0.f); float a = sc[r]; asm("v_fmac_f32 %0, %1, %2" : "+v"(a) : "v"(t), "v"(wi[hd])); sc[r] = a; }
    __builtin_amdgcn_sched_barrier(0);
  }
}
DI unsigned ord_key(float f) { const unsigned u = __float_as_uint(f); return (u & 0x80000000u) ? ~u : (u | 0x80000000u); }
constexpr int HROW = 1040;
DI void indexer_item(const Params& P, unsigned char* lds, int e, int g) {
  const Entry E = get_entry(e);
  const int tid = threadIdx.x, w = tid >> 6, lane = tid & 63, n = lane & 31, h = lane >> 5;
  const int tq = 32 * g + n; const bool qvalid = tq < E.Tq; const int tqc = qvalid ? tq : E.Tq - 1;
  const int vend = qvalid ? vis_end(E.samp, tqc) : 0;
  const int tq_last = min(32 * g + 31, E.Tq - 1); const int vmax = vis_end(E.samp, tq_last); const int nblk = (vmax + 31) >> 5;
  const bf16_t* QIB = (const bf16_t*)(P.ws + R_QIB); const bf16_t* KIB = (const bf16_t*)(P.ws + R_KIB); const float* WIB = (const float*)(P.ws + R_WIB);
  unsigned short* MASK = (unsigned short*)(P.ws + R_MASK);
  bf16x8 qif[4][4];
  unsigned char* qlds_base = lds + 32 * HROW * 4 + 256;
  { const bf16_t* qip = QIB + (size_t)(E.qrow0 + tqc) * 512 + 8 * h;
#pragma unroll
    for (int hd = 0; hd < 4; ++hd)
#pragma unroll
      for (int s = 0; s < 4; ++s) qif[hd][s] = *(const bf16x8*)(qip + hd * 64 + 16 * s);
#pragma unroll
    for (int i = 0; i < 2; ++i) { const int hd = 4 + (w >> 1), s = 2 * (w & 1) + i;
      *(bf16x8*)(qlds_base + ((hd - 4) * 4 + s) * 1024 + lane * 16) = *(const bf16x8*)(qip + hd * 64 + 16 * s); } }
  const unsigned char* qlds = qlds_base + lane * 16;
  __syncthreads();
  float wi[8];
  { const f32x4 a = *(const f32x4*)(WIB + (size_t)(E.qrow0 + tqc) * 8), b = *(const f32x4*)(WIB + (size_t)(E.qrow0 + tqc) * 8 + 4);
    wi[0] = a[0]; wi[1] = a[1]; wi[2] = a[2]; wi[3] = a[3]; wi[4] = b[0]; wi[5] = b[1]; wi[6] = b[2]; wi[7] = b[3]; }
  unsigned* hist = (unsigned*)lds; unsigned* pref = (unsigned*)(lds + 32 * HROW * 4); unsigned* krem = pref + 32;
  const bf16_t* kbase = KIB + (size_t)(E.krow0 + pi_row(n)) * IDXD + 8 * h;
  unsigned thr = 0u;
  if (vmax > TOPK) {
    if (tid < 32) { pref[tid] = 0u; krem[tid] = TOPK; }
    for (int p = 0; p < 3; ++p) {
      const int shift = p == 0 ? 21 : (p == 1 ? 10 : 0); const unsigned dmask = p == 2 ? 0x3FFu : 0x7FFu; const int pshift = p == 1 ? 21 : 10;
      for (int i = tid; i < 32 * HROW / 4; i += 512) ((u32x4*)hist)[i] = (u32x4){0u, 0u, 0u, 0u};
      __syncthreads();
      const unsigned mypref = pref[n];
      for (int blk = w; blk < nblk; blk += 8) {
        f32x16 sc; idx_scores(sc, qif, qlds, wi, kbase + (size_t)blk * 32 * IDXD);
#pragma unroll
        for (int r = 0; r < 16; ++r) {
          const int kpos = 32 * blk + 16 * h + r; const unsigned ok = ord_key(sc[r]);
          const bool match = kpos < vend && (p == 0 || (ok >> pshift) == mypref);
          if (match) { const unsigned d = (ok >> shift) & dmask, wd = d >> 1; atomicAdd(&hist[n * HROW + wd + (wd >> 6)], 1u << (16 * (d & 1u))); }
        }
      }
      __syncthreads();
      { const int q = tid >> 4, j = tid & 15, seg = 15 - j; const unsigned* hq = hist + q * HROW + seg * 65;
        unsigned s = 0;
        for (int i = 0; i < 64; ++i) { const unsigned x = hq[i]; s += (x & 0xffffu) + (x >> 16); }
        unsigned incl = s;
#pragma unroll
        for (int off = 1; off < 16; off <<= 1) { const unsigned t = __shfl_up(incl, off, 16); if (j >= off) incl += t; }
        const unsigned above = incl - s, kr = krem[q], pold = pref[q];
        if (above < kr && kr <= above + s) {
          unsigned c = above; int bin = 0; unsigned newk = 1;
          for (int i = 63; i >= 0; --i) { const unsigned x = hq[i], hi = x >> 16, lo = x & 0xffffu;
            if (c + hi >= kr) { bin = 128 * seg + 2 * i + 1; newk = kr - c; break; } c += hi;
            if (c + lo >= kr) { bin = 128 * seg + 2 * i; newk = kr - c; break; } c += lo; }
          pref[q] = p == 0 ? (unsigned)bin : ((pold << (p == 1 ? 11 : 10)) | (unsigned)bin); krem[q] = newk;
        }
      }
      __syncthreads();
    }
    thr = pref[n]; if (vend <= TOPK) thr = 0u;
  }
  for (int blk = w; blk < nblk; blk += 8) {
    f32x16 sc; idx_scores(sc, qif, qlds, wi, kbase + (size_t)blk * 32 * IDXD);
    unsigned bits = 0u;
#pragma unroll
    for (int r = 0; r < 16; ++r) { const int kpos = 32 * blk + 16 * h + r; const unsigned ok = ord_key(sc[r]); if (kpos < vend && ok >= thr) bits |= 1u << r; }
    if (qvalid) MASK[E.mask_off + ((size_t)blk * E.Tq + tq) * 2 + h] = (unsigned short)bits;
  }
  __syncthreads();
}
DI void indexer_phase(const Params& P, unsigned char* lds) {
  constexpr int NIT = NB * 257 + DB;
  const int G = gridDim.x;
  for (int round = 0; round * G < NIT; ++round) {
    const int it = snake_item(round, blockIdx.x, G); if (it >= NIT) continue;
    const bool pr = it < NB * 257; indexer_item(P, lds, pr ? (it & 3) : NB + (it - NB * 257), pr ? 256 - (it >> 2) : 0);
  }
}
constexpr int KT_K = 64 * 272, KT_V = 128 * 144, KT_STAGE = KT_K + KT_V;
DI void dsa_attn_item(const Params& P, unsigned char* lds, int e, int head, int qt) {
  const Entry E = get_entry(e);
  const int tid = threadIdx.x, w = tid >> 6, lane = tid & 63, n = lane & 31, h = lane >> 5;
  const int wq0 = qt * 256 + w * 32, tq = wq0 + n; const bool qvalid = tq < E.Tq; const int tqc = qvalid ? tq : E.Tq - 1;
  const int qpos = E.qpos0 + tqc;
  const int nkt = (vis_end(E.samp, min(qt * 256 + 255, E.Tq - 1)) + 63) >> 6;
  const int wvmax = wq0 < E.Tq ? vis_end(E.samp, min(wq0 + 31, E.Tq - 1)) : 0;
  const bf16_t* QB = (const bf16_t*)(P.ws + R_QB); const bf16_t* KB = (const bf16_t*)(P.ws + R_KB);
  const bf16_t* VTb = (const bf16_t*)(P.ws + (E.samp ? R_VTS : R_VT)) + E.vt_off + (size_t)head * HDIM * E.pitch;
  const unsigned short* MASK = (const unsigned short*)(P.ws + R_MASK) + E.mask_off + (size_t)tqc * 2 + h;
  bf16_t* OB = (bf16_t*)(P.ws + R_OB);
  float* biasl = (float*)(lds + 2 * KT_STAGE);
  if (tid < 257) biasl[tid] = P.in[I_RELB][rel_bucket(tid - 128) * NH + head];
  bf16x8 qf[8];
  { const bf16_t* qp = QB + (size_t)(E.qrow0 + tqc) * D + head * HDIM + 8 * h;
#pragma unroll
    for (int s = 0; s < 8; ++s) qf[s] = *(const bf16x8*)(qp + 16 * s); }
  f32x16 o[4];
#pragma unroll
  for (int db = 0; db < 4; ++db)
#pragma unroll
    for (int r = 0; r < 16; ++r) o[db][r] = 0.f;
  float m = -1e30f, lsum = 0.f;
  const bf16_t* gK[2]; const bf16_t* gV[2]; int lK[2], lV[2];
#pragma unroll
  for (int i = 0; i < 2; ++i) { const int c = tid + 512 * i;
    gK[i] = KB + (size_t)(E.krow0 + (c >> 4)) * D + head * HDIM + (c & 15) * 8; lK[i] = (c >> 4) * 272 + (c & 15) * 16;
    gV[i] = VTb + (size_t)(c >> 3) * E.pitch + (c & 7) * 8; lV[i] = KT_K + (c >> 3) * 144 + (c & 7) * 16; }
  bf16x8 rk[2], rv[2];
#pragma unroll
  for (int i = 0; i < 2; ++i) { rk[i] = *(const bf16x8*)gK[i]; rv[i] = *(const bf16x8*)gV[i]; }
#pragma unroll
  for (int i = 0; i < 2; ++i) { *(bf16x8*)(lds + lK[i]) = rk[i]; *(bf16x8*)(lds + lV[i]) = rv[i]; }
  __syncthreads();
  const int arow = pi_row(n) * 272 + 16 * h;
  const int vrow = n * 144 + 32 * h;
  for (int kt = 0; kt < nkt; ++kt) {
    const int buf = kt & 1; const bool more = kt + 1 < nkt;
    if (more) {
#pragma unroll
      for (int i = 0; i < 2; ++i) { rk[i] = *(const bf16x8*)(gK[i] + (size_t)(kt + 1) * 64 * D); rv[i] = *(const bf16x8*)(gV[i] + (kt + 1) * 64); }
    }
    if (64 * kt < wvmax) {
      const unsigned char* sK = lds + buf * KT_STAGE; const unsigned char* sV = sK + KT_K;
      f32x16 s0, s1;
#pragma unroll
      for (int r = 0; r < 16; ++r) { s0[r] = 0.f; s1[r] = 0.f; }
#pragma unroll
      for (int s = 0; s < 8; ++s) {
        const bf16x8 k0 = *(const bf16x8*)(sK + arow + 32 * s), k1 = *(const bf16x8*)(sK + 32 * 272 + arow + 32 * s);
        s0 = MFMA32(k0, qf[s], s0); s1 = MFMA32(k1, qf[s], s1);
      }
      unsigned bits0 = 0u, bits1 = 0u;
      if (qvalid) { bits0 = MASK[(size_t)(2 * kt) * E.Tq * 2]; if (64 * kt + 32 < wvmax) bits1 = MASK[(size_t)(2 * kt + 1) * E.Tq * 2]; }
      float mx = -1e30f;
      const int rel0 = 64 * kt + 16 * h - qpos;
#pragma unroll
      for (int r = 0; r < 16; ++r) {
        const int i0 = min(max(rel0 + r, -128), 128) + 128, i1 = min(max(rel0 + r + 32, -128), 128) + 128;
        s0[r] += biasl[i0]; s1[r] += biasl[i1];
        if ((bits0 >> r) & 1u) mx = fmaxf(mx, s0[r]);
        if ((bits1 >> r) & 1u) mx = fmaxf(mx, s1[r]);
      }
      mx = fmaxf(mx, __shfl_xor(mx, 32));
      const float mn = fmaxf(m, mx), scale = __expf(m - mn); m = mn; lsum *= scale;
#pragma unroll
      for (int db = 0; db < 4; ++db)
#pragma unroll
        for (int r = 0; r < 16; ++r) o[db][r] *= scale;
      float ps = 0.f;
#pragma unroll
      for (int r = 0; r < 16; ++r) {
        s0[r] = ((bits0 >> r) & 1u) ? __expf(s0[r] - mn) : 0.f; s1[r] = ((bits1 >> r) & 1u) ? __expf(s1[r] - mn) : 0.f; ps += s0[r] + s1[r];
      }
      lsum += ps;
#pragma unroll
      for (int s2 = 0; s2 < 2; ++s2) {
        const bf16x8 p0 = pk8(s0[8 * s2], s0[8 * s2 + 1], s0[8 * s2 + 2], s0[8 * s2 + 3], s0[8 * s2 + 4], s0[8 * s2 + 5], s0[8 * s2 + 6], s0[8 * s2 + 7]);
        const bf16x8 p1 = pk8(s1[8 * s2], s1[8 * s2 + 1], s1[8 * s2 + 2], s1[8 * s2 + 3], s1[8 * s2 + 4], s1[8 * s2 + 5], s1[8 * s2 + 6], s1[8 * s2 + 7]);
#pragma unroll
        for (int db = 0; db < 4; ++db) {
          const bf16x8 v0 = *(const bf16x8*)(sV + db * 32 * 144 + vrow + 16 * s2), v1 = *(const bf16x8*)(sV + db * 32 * 144 + vrow + 64 + 16 * s2);
          o[db] = MFMA32(v0, p0, o[db]); o[db] = MFMA32(v1, p1, o[db]);
        }
      }
    }
    if (more) {
      unsigned char* nb = lds + (buf ^ 1) * KT_STAGE;
#pragma unroll
      for (int i = 0; i < 2; ++i) { *(bf16x8*)(nb + lK[i]) = rk[i]; *(bf16x8*)(nb + lV[i]) = rv[i]; }
    }
    __syncthreads();
  }
  lsum += __shfl_xor(lsum, 32);
  if (qvalid) {
    const float inv = 1.f / lsum; bf16_t* op = OB + (size_t)(E.qrow0 + tq) * D + head * HDIM + 4 * h;
#pragma unroll
    for (int db = 0; db < 4; ++db)
#pragma unroll
      for (int g4 = 0; g4 < 4; ++g4) { u32x2 pk = {pk2(o[db][4 * g4] * inv, o[db][4 * g4 + 1] * inv), pk2(o[db][4 * g4 + 2] * inv, o[db][4 * g4 + 3] * inv)};
        *(u32x2*)(op + 32 * db + 8 * g4) = pk; }
  }
}
DI void dsa_attn_phase(const Params& P, unsigned char* lds) {
  constexpr int NPI = NB * NH * 33, NIT = NPI + DB * NH;
  const int G = gridDim.x;
  for (int round = 0; round * G < NIT; ++round) {
    const int it = snake_item(round, blockIdx.x, G); if (it >= NIT) continue;
    const bool pr = it < NPI; const int s = it - NPI; dsa_attn_item(P, lds, pr ? (it & 3) : NB + (s >> 3), pr ? ((it >> 2) & 7) : (s & 7), pr ? 32 - (it >> 5) : 0);
  }
}
DI void sb_item(const Params& P, int e, int head, int g, int lane) {
  const Entry E = get_entry(e);
  const int n = lane & 31, h = lane >> 5;
  const int tq = 32 * g + n; const bool qvalid = tq < E.Tq; const int tqc = qvalid ? tq : E.Tq - 1; const int qpos = E.qpos0 + tqc;
  const bf16_t* QB = (const bf16_t*)(P.ws + R_QB); const bf16_t* KB = (const bf16_t*)(P.ws + R_KB);
  const bf16_t* VTb = (const bf16_t*)(P.ws + (E.samp ? R_VTS : R_VT)) + E.vt_off + (size_t)head * HDIM * E.pitch;
  bf16_t* OB = (bf16_t*)(P.ws + R_OB);
  bf16x8 qf[8];
  { const bf16_t* qp = QB + (size_t)(E.qrow0 + tqc) * D + head * HDIM + 8 * h;
#pragma unroll
    for (int s = 0; s < 8; ++s) qf[s] = *(const bf16x8*)(qp + 16 * s); }
  f32x16 o[4];
#pragma unroll
  for (int db = 0; db < 4; ++db)
#pragma unroll
    for (int r = 0; r < 16; ++r) o[db][r] = 0.f;
  float carry = 0.f;
  const bf16_t* kp0 = KB + (size_t)(E.krow0 + pi_row(n)) * D + head * HDIM + 8 * h;
  const bf16_t* vp0 = VTb + (size_t)n * E.pitch + 16 * h;
  for (int kb = (E.qpos0 + 32 * g) >> 5; kb >= 0; --kb) {
    bf16x8 kf[8];
#pragma unroll
    for (int s = 0; s < 8; ++s) kf[s] = *(const bf16x8*)(kp0 + (size_t)kb * 32 * D + 16 * s);
    bf16x8 vf[4][2];
#pragma unroll
    for (int db = 0; db < 4; ++db)
#pragma unroll
      for (int s2 = 0; s2 < 2; ++s2) vf[db][s2] = *(const bf16x8*)(vp0 + (size_t)db * 32 * E.pitch + kb * 32 + 8 * s2);
    f32x16 z;
#pragma unroll
    for (int r = 0; r < 16; ++r) z[r] = 0.f;
#pragma unroll
    for (int s = 0; s < 8; ++s) z = MFMA32(kf[s], qf[s], z);
    float ls[16], bt[16]; float run = 0.f;
#pragma unroll
    for (int r = 15; r >= 0; --r) {
      const int kpos = 32 * kb + 16 * h + r; const bool causal = qvalid && kpos < qpos;
      const float zz = z[r], sp = fmaxf(zz, 0.f) + __logf(1.f + __expf(-fabsf(zz)));
      ls[r] = causal ? zz - sp : -1e30f;
      bt[r] = run; run += causal ? -sp : 0.f;
    }
    const float other = __shfl_xor(run, 32);
    const float base = carry + (h == 0 ? other : 0.f);
    float a[16];
#pragma unroll
    for (int r = 0; r < 16; ++r) a[r] = ls[r] > -1e29f ? __expf(ls[r] + base + bt[r]) : 0.f;
    carry += run + other;
#pragma unroll
    for (int s2 = 0; s2 < 2; ++s2) {
      const bf16x8 pf = pk8(a[8 * s2], a[8 * s2 + 1], a[8 * s2 + 2], a[8 * s2 + 3], a[8 * s2 + 4], a[8 * s2 + 5], a[8 * s2 + 6], a[8 * s2 + 7]);
#pragma unroll
      for (int db = 0; db < 4; ++db) o[db] = MFMA32(vf[db][s2], pf, o[db]);
    }
    const bool done = !qvalid || carry < -30.f;
    if (__all(done)) break;
  }
  if (qvalid) {
    bf16_t* op = OB + (size_t)(E.qrow0 + tq) * D + head * HDIM + 4 * h;
#pragma unroll
    for (int db = 0; db < 4; ++db)
#pragma unroll
      for (int g4 = 0; g4 < 4; ++g4) { u32x2 pk = {pk2(o[db][4 * g4], o[db][4 * g4 + 1]), pk2(o[db][4 * g4 + 2], o[db][4 * g4 + 3])};
        *(u32x2*)(op + 32 * db + 8 * g4) = pk; }
  }
}
DI void sb_phase(const Params& P) {
  constexpr int NPI = NB * NH * 257, NIT = NPI + DB * NH;
  const int lane = threadIdx.x & 63, gw = blockIdx.x * 8 + (threadIdx.x >> 6), GW = gridDim.x * 8;
  for (int round = 0; round * GW < NIT; ++round) {
    const int it = snake_item(round, gw, GW); if (it >= NIT) continue;
    const bool pr = it < NPI; const int s = it - NPI; sb_item(P, pr ? (it & 3) : NB + (s >> 3), pr ? ((it >> 2) & 7) : (s & 7), pr ? 256 - (it >> 5) : 0, lane);
  }
}

#define KDEF(name, ...) __global__ void __launch_bounds__(512, 2) name(Params P, int l) { extern __shared__ __attribute__((aligned(16))) unsigned char shm[]; unsigned char* lds = shm; const bool isA = !(l & 1); const int j = l >> 1; (void)isA; (void)j; (void)lds; __VA_ARGS__ }
KDEF(k_phase0, phase0(P, lds);)
KDEF(k_cache, cache_phase(P, lds, isA, j);)
KDEF(k_inproj, { EpiInProj E{isA ? 1 : 0, j, P.out, P.ws}; const bf16_t* XB = (const bf16_t*)(P.ws + WS_XB);
      if (isA) run_gemm(lds, XB, (const bf16_t*)(P.ws + W_AIN) + (size_t)j * A_IN_PAD * D, M_PAD, A_IN_PAD, D, E);
      else run_gemm(lds, XB, (const bf16_t*)(P.ws + W_BIN) + (size_t)j * B_IN * D, M_PAD, B_IN, D, E); })
KDEF(k_indexer, indexer_phase(P, lds);)
KDEF(k_dsa, dsa_attn_phase(P, lds);)
KDEF(k_sb, sb_phase(P);)
KDEF(k_outproj, { EpiResid E{(float*)(P.ws + WS_X)}; run_gemm(lds, (const bf16_t*)(P.ws + R_OB), (const bf16_t*)(P.ws + (isA ? W_AOUT : W_BOUT)) + (size_t)j * D * D, M_PAD, D, D, E); })
KDEF(k_ln1, ln_phase(P, P.in[I_LN1G] + l * D, P.in[I_LN1B] + l * D, false);)
KDEF(k_ffn1, { EpiFFN1 E{l, P.out, P.ws}; run_gemm(lds, (const bf16_t*)(P.ws + WS_XB), (const bf16_t*)(P.ws + W_FFN1) + (size_t)l * 2 * DFF * D, M_PAD, 2 * DFF, D, E); })
KDEF(k_conv, conv_phase(P, l);)
KDEF(k_ffn2, { EpiResid E{(float*)(P.ws + WS_X)}; run_gemm(lds, (const bf16_t*)(P.ws + R_H), (const bf16_t*)(P.ws + W_FFN2) + (size_t)l * D * DFF, M_PAD, D, DFF, E); })
KDEF(k_ln2, ln_phase(P, P.in[I_LN2G] + l * D, P.in[I_LN2B] + l * D, l == 3);)

extern "C" void kernel_launch(void* const* d_in, const int* in_sizes, int n_in, void* d_out, int out_size, void* d_ws, size_t ws_size, hipStream_t stream) {
  static int inited = 0;
  const void* ks[] = {(const void*)k_phase0, (const void*)k_cache, (const void*)k_inproj, (const void*)k_indexer, (const void*)k_dsa, (const void*)k_sb, (const void*)k_outproj,
                      (const void*)k_ln1, (const void*)k_ffn1, (const void*)k_conv, (const void*)k_ffn2, (const void*)k_ln2};
  if (!inited) { for (auto k : ks) (void)hipFuncSetAttribute(k, hipFuncAttributeMaxDynamicSharedMemorySize, LDS_BYTES); inited = 1; }
  Params p{};
  for (int i = 0; i < 23; ++i) p.in[i] = (const float*)d_in[i];
  p.out = (float*)d_out; p.ws = (unsigned char*)d_ws;
  if (ws_size < WS_NEED) { fprintf(stderr, "workspace too small: %zu < %zu\n", ws_size, (size_t)WS_NEED); }
  const dim3 G(256), B(512);
#define L(k, l) hipLaunchKernelGGL(k, G, B, LDS_BYTES, stream, p, l)
  L(k_phase0, 0);
  for (int l = 0; l < 4; ++l) {
    L(k_cache, l); L(k_inproj, l);
    if (!(l & 1)) { L(k_indexer, l); L(k_dsa, l); } else L(k_sb, l);
    L(k_outproj, l); L(k_ln1, l); L(k_ffn1, l); L(k_conv, l); L(k_ffn2, l); L(k_ln2, l);
  }
}
```

```cpp
#include <hip/hip_runtime.h>
#include <hip/hip_cooperative_groups.h>
#include <cstdio>
namespace cg = cooperative_groups;
namespace pg8 {
#define PG8_LAS __attribute__((address_space(3)))
typedef unsigned short bf16_t;
typedef short bf16x8 __attribute__((ext_vector_type(8)));
typedef float f32x4 __attribute__((ext_vector_type(4)));
typedef unsigned u32x4 __attribute__((ext_vector_type(4)));
constexpr int BM = 256, BK = 64, HALF = 128, HTB = HALF * BK * 2  , STAGE_BYTES = 8 * HTB, NXCD = 8, WGM = 8;

__host__ __device__ __forceinline__ int lds_byte(int r, int c) { const int st = (r >> 4) * 2 + (c >> 5), rr = r & 15, cc = c & 31, ob = rr * 64 + cc * 2; return st * 1024 + (ob ^ (((ob >> 9) & 1) << 5)); }
__host__ __device__ __forceinline__ void stage_rc(int b, int& R, int& C) { const int st = b / 1024, sb = b % 1024, swz = sb ^ (((sb >> 9) & 1) << 5); R = (st >> 1) * 16 + swz / 64; C = (st & 1) * 32 + (swz % 64) / 2; }
__host__ __device__ __forceinline__ int perm32(int rho) { const int n = rho >> 4, i = rho & 15; return 8 * (i >> 2) + 4 * n + (i & 3); }

struct Unit { int pm, pn; };
struct Gemm { const bf16_t* A; const bf16_t* Bt; int M, N, K; };

struct StaticOrder {
    int nM, nN, nwg, G, c;
    __host__ __device__ void init(int M, int N, int G_, int c_) { nM = M / BM; nN = N / BM; nwg = nM * nN; G = G_; c = c_; }
    __host__ __device__ bool next(int i, Unit& u) const {
        const long L = (long)i * G + c; if (L >= nwg) return false;
        int wgid = (int)L; { const int q = nwg / NXCD, r = nwg % NXCD, xcd = wgid % NXCD, off = wgid / NXCD; wgid = (xcd < r ? xcd * (q + 1) : r * (q + 1) + (xcd - r) * q) + off; }
        const int nig = WGM * nN, gid = wgid / nig, fm = gid * WGM, gsz = (nM - fm) < WGM ? (nM - fm) : WGM;
        u.pm = fm + ((wgid % nig) % gsz); u.pn = (wgid % nig) / gsz; return true;
    }
    __device__ __forceinline__ void a_ready(const Unit&) const {}
    __device__ __forceinline__ void done(const Unit&) const {}
};
template <class Epi, class Sched, bool STAMP = false>
__device__ __forceinline__ void gemm_phase(PG8_LAS unsigned char* lds, const Gemm g, const Sched& S, const Epi& E, unsigned long long* stamps) {
    int tid_l = threadIdx.x; asm volatile("" : "+v"(tid_l)); const int tid = tid_l, wid = __builtin_amdgcn_readfirstlane(tid >> 6), lane = tid & 63, wr = wid >> 2, wc = wid & 3, fr = lane & 15, fq = lane >> 4;
    const int K = g.K, nt = K / BK;
    int ts_lo = 0, ts_hi = 0, nts = 0; const unsigned long long rt_entry = STAMP ? (unsigned long long)wall_clock64() : 0ull;
#define PG8_STAMP() do { if (STAMP && wid == 0 && nts < 64) { const unsigned long long _c = (unsigned long long)clock64(); \
        ts_lo = (lane == nts) ? (int)(unsigned)_c : ts_lo; ts_hi = (lane == nts) ? (int)(unsigned)(_c >> 32) : ts_hi; ++nts; } } while (0)
    PG8_STAMP();
    unsigned voffA[2], voffB[2];
#pragma unroll
    for (int i = 0; i < 2; ++i) { int R, C; stage_rc(tid * 16 + i * 8192, R, C); const int Rb = Epi::PERM ? ((R & ~31) + perm32(R & 31)) : R;
        voffA[i] = (unsigned)(R * K + C) * 2u; voffB[i] = (unsigned)(Rb * K + C) * 2u; }
    const size_t kstep = (size_t)(BK * 2);
    const size_t hstep = (size_t)HALF * K * 2;
    const size_t tstep = 2 * hstep;
    const unsigned ldsw = (unsigned)wid * 1024u;
    const int aoff = lds_byte(wr * 64 + fr, fq * 8), boff = lds_byte(wc * 32 + fr, fq * 8);
#define PG8_SA(b, h) (((b) * 2 + (h)) * HTB)
#define PG8_SB(b, h) ((4 + (b) * 2 + (h)) * HTB)
#define PG8_STAGE(bufoff, gbase, voff) do { _Pragma("unroll") for (int _i = 0; _i < 2; ++_i) \
        __builtin_amdgcn_global_load_lds((const unsigned*)((const char*)(gbase) + (voff)[_i]), (PG8_LAS unsigned*)(lds + (bufoff) + ldsw + _i * 8192), 16, 0, 0); } while (0)
#define PG8_LDA(dst, b, h) do { _Pragma("unroll") for (int m = 0; m < 4; ++m) _Pragma("unroll") for (int k = 0; k < 2; ++k) dst[m][k] = *(const PG8_LAS bf16x8*)(lds + PG8_SA(b, h) + aoff + m * 2048 + k * 1024); } while (0)
#define PG8_LDB(dst, b, h) do { _Pragma("unroll") for (int n = 0; n < 2; ++n) _Pragma("unroll") for (int k = 0; k < 2; ++k) dst[n][k] = *(const PG8_LAS bf16x8*)(lds + PG8_SB(b, h) + boff + n * 2048 + k * 1024); } while (0)
#define PG8_MMA(ai, bj, At, Bt) do { __builtin_amdgcn_s_setprio(1); _Pragma("unroll") for (int m = 0; m < 4; ++m) _Pragma("unroll") for (int n = 0; n < 2; ++n) _Pragma("unroll") for (int k = 0; k < 2; ++k) \
        acc[ai][bj][m][n] = __builtin_amdgcn_mfma_f32_16x16x32_bf16(Bt[n][k], At[m][k], acc[ai][bj][m][n], 0, 0, 0); __builtin_amdgcn_s_setprio(0); } while (0)
#define PG8_WAIT_V(n) asm volatile("s_waitcnt vmcnt(" #n ")" ::: "memory")
#define PG8_WAIT_L(n) asm volatile("s_waitcnt lgkmcnt(" #n ")" ::: "memory")
#define PG8_BAR __builtin_amdgcn_s_barrier()
#define PG8_SCHED __builtin_amdgcn_sched_barrier(0)
    Unit cur, nxt; int ui = 0;
    if (!S.next(0, cur)) return;
    f32x4 acc[2][2][4][2];
#pragma unroll
    for (int a = 0; a < 2; ++a)
#pragma unroll
        for (int b = 0; b < 2; ++b)
#pragma unroll
            for (int m = 0; m < 4; ++m)
#pragma unroll
                for (int n = 0; n < 2; ++n) acc[a][b][m][n] = (f32x4){0.f, 0.f, 0.f, 0.f};
    bf16x8 At[4][2], B0[2][2], B1[2][2];
    const char* cA = (const char*)g.A + (size_t)cur.pm * tstep; const char* cB = (const char*)g.Bt + (size_t)cur.pn * tstep;
    S.a_ready(cur);
    PG8_STAGE(PG8_SB(0, 0), cB, voffB); PG8_STAGE(PG8_SA(0, 0), cA, voffA); PG8_STAGE(PG8_SB(0, 1), cB + hstep, voffB); PG8_STAGE(PG8_SA(0, 1), cA + hstep, voffA);
    if (wr == 1) PG8_BAR;
    PG8_WAIT_V(4); PG8_BAR;
    PG8_STAGE(PG8_SB(1, 0), cB + kstep, voffB); PG8_STAGE(PG8_SA(1, 0), cA + kstep, voffA); PG8_STAGE(PG8_SB(1, 1), cB + hstep + kstep, voffB);
    PG8_WAIT_V(6); PG8_BAR;
    PG8_STAMP();
    for (;;) {
        const bool has_next = S.next(ui + 1, nxt);
        const char* nA = has_next ? (const char*)g.A + (size_t)nxt.pm * tstep : cA; const char* nB = has_next ? (const char*)g.Bt + (size_t)nxt.pn * tstep : cB;
        for (int t = 0; t < nt; t += 2) {
            const bool last = (t == nt - 2);
            const char* a1 = cA + (size_t)(t + 1) * kstep;
            const char* a2 = last ? nA : cA + (size_t)(t + 2) * kstep; const char* b2 = last ? nB : cB + (size_t)(t + 2) * kstep;
            const char* a3 = a2 + kstep; const char* b3 = b2 + kstep;
            if (last && has_next) S.a_ready(nxt);
            PG8_LDB(B0, 0, 0); PG8_SCHED; PG8_LDA(At, 0, 0); PG8_STAGE(PG8_SA(1, 1), a1 + hstep, voffA);
            PG8_WAIT_L(8); PG8_BAR; PG8_WAIT_L(0); PG8_MMA(0, 0, At, B0); PG8_BAR; PG8_SCHED;
            PG8_LDB(B1, 0, 1); PG8_STAGE(PG8_SB(0, 0), b2, voffB);
            PG8_BAR; PG8_WAIT_L(0); PG8_MMA(0, 1, At, B1); PG8_BAR;
            PG8_LDA(At, 0, 1); PG8_STAGE(PG8_SA(0, 0), a2, voffA);
            PG8_BAR; PG8_WAIT_L(0); PG8_MMA(1, 0, At, B0); PG8_BAR; PG8_SCHED;
            PG8_STAGE(PG8_SB(0, 1), b2 + hstep, voffB);
            PG8_WAIT_V(6); PG8_BAR; PG8_MMA(1, 1, At, B1); PG8_BAR;
            PG8_LDB(B0, 1, 0); PG8_SCHED; PG8_LDA(At, 1, 0); PG8_STAGE(PG8_SA(0, 1), a2 + hstep, voffA);
            PG8_WAIT_L(8); PG8_BAR; PG8_WAIT_L(0); PG8_MMA(0, 0, At, B0); PG8_BAR; PG8_SCHED;
            PG8_LDB(B1, 1, 1); PG8_STAGE(PG8_SB(1, 0), b3, voffB);
            PG8_BAR; PG8_WAIT_L(0); PG8_MMA(0, 1, At, B1); PG8_BAR;
            PG8_LDA(At, 1, 1); PG8_STAGE(PG8_SA(1, 0), a3, voffA);
            PG8_BAR; PG8_WAIT_L(0); PG8_MMA(1, 0, At, B0); PG8_BAR; PG8_SCHED;
            PG8_STAGE(PG8_SB(1, 1), b3 + hstep, voffB);
            PG8_WAIT_V(6); PG8_BAR; PG8_MMA(1, 1, At, B1); PG8_BAR;
        }
        PG8_STAMP();
        if constexpr (!Epi::AFTER_DRAIN) { E(acc, cur, wr, wc, fr, fq); S.done(cur); }
        PG8_STAMP();
        if (!has_next) break;
#pragma unroll
        for (int a = 0; a < 2; ++a)
#pragma unroll
            for (int b = 0; b < 2; ++b)
#pragma unroll
                for (int m = 0; m < 4; ++m)
#pragma unroll
                    for (int n = 0; n < 2; ++n) acc[a][b][m][n] = (f32x4){0.f, 0.f, 0.f, 0.f};
        cur = nxt; cA = nA; cB = nB; ++ui;
    }
    PG8_WAIT_V(0);
    if (wr == 0) PG8_BAR;
    PG8_BAR;
    if constexpr (Epi::AFTER_DRAIN) { E.fused(acc, cur, wr, wc, fr, fq, lds, wid, lane); S.done(cur); }
    PG8_STAMP();
    if (STAMP && wid == 0) { stamps[lane] = lane < nts ? (((unsigned long long)(unsigned)ts_hi << 32) | (unsigned)ts_lo) : 0ull;
        if (lane == 62) stamps[62] = rt_entry; if (lane == 63) stamps[63] = (unsigned long long)wall_clock64(); }
#undef PG8_STAMP
#undef PG8_SA
#undef PG8_SB
#undef PG8_STAGE
#undef PG8_LDA
#undef PG8_LDB
#undef PG8_MMA
#undef PG8_WAIT_V
#undef PG8_WAIT_L
#undef PG8_BAR
#undef PG8_SCHED
}
}
using pg8::bf16_t; using pg8::bf16x8; using pg8::f32x4; using pg8::u32x4;
typedef float f32x16 __attribute__((ext_vector_type(16)));
typedef float f32x2 __attribute__((ext_vector_type(2)));
typedef __bf16 bf2_t __attribute__((ext_vector_type(2)));
typedef unsigned u32x2 __attribute__((ext_vector_type(2)));
#define DI __device__ __forceinline__
#define LAS __attribute__((address_space(3)))
DI int ltid() { int t = threadIdx.x; asm volatile("" : "+v"(t)); return t; }
#define MFMA32(a, b, c) __builtin_amdgcn_mfma_f32_32x32x16_bf16((a), (b), (c), 0, 0, 0)

constexpr int D = 1024, NB = 4, SEQ = 8192, NMETA = 16, LP = NMETA + SEQ  , DB = 8, DSEQ = 16, PAST = 2048, LS = PAST + DSEQ  ;
constexpr int NH = 8, HDIM = 128, IDXD = 64, IH = 8, DFF = 2816, TOPK = 256;
constexpr int M_P = NB * LP  , M_S = DB * DSEQ  , M_ALL = M_P + M_S  , M_PAD = 33024, M_MAIN = 32768  ;
constexpr int A_IN = 3656, A_IN_PAD = 3840, B_IN = 3072;
constexpr int LPP = 8256, LSP = 2112;
constexpr int KR_TOT = M_P + DB * LS  , KR_PAD = 49408;
constexpr int NKB_P = 258, NKB_S = 66;
constexpr float ALPHA = 1.6817928305074290f;
constexpr float QSCALE = 0.08838834764831845f;
constexpr float LOG2E = 1.4426950408889634f;
constexpr float WISCALE = 0.04419417382415922f;
constexpr float LN_EPS = 1e-5f;

constexpr size_t O_YP = 0, O_YS = O_YP + (size_t)NB * SEQ * D, O_AKP = O_YS + (size_t)M_S * D, O_AVP = O_AKP + 2ull * M_P * D, O_AIKP = O_AVP + 2ull * M_P * D,
                 O_BKP = O_AIKP + 2ull * M_P * IDXD, O_BVP = O_BKP + 2ull * M_P * D, O_CONVP = O_BVP + 2ull * M_P * D, O_AKS = O_CONVP + 4ull * NB * 2 * DFF,
                 O_AVS = O_AKS + 2ull * M_S * D, O_AIKS = O_AVS + 2ull * M_S * D, O_BKS = O_AIKS + 2ull * M_S * IDXD, O_BVS = O_BKS + 2ull * M_S * D,
                 O_CONVS = O_BVS + 2ull * M_S * D, O_END = O_CONVS + 4ull * DB * 2 * DFF;

constexpr size_t al256(size_t x) { return (x + 255) & ~(size_t)255; }
constexpr size_t W_AIN = 0, W_AOUT = W_AIN + 2ull * A_IN_PAD * D * 2, W_BIN = W_AOUT + 2ull * D * D * 2, W_BOUT = W_BIN + 2ull * B_IN * D * 2,
                 W_FFN1 = W_BOUT + 2ull * D * D * 2, W_FFN2 = W_FFN1 + 4ull * 2 * DFF * D * 2, W_END = W_FFN2 + 4ull * D * DFF * 2;
constexpr size_t WS_X = al256(W_END), WS_XB = WS_X + (size_t)M_PAD * D * 4, WS_KS = WS_XB + (size_t)M_PAD * D * 2;
constexpr size_t WS_R1 = al256(WS_KS);
constexpr size_t R_QB = WS_R1, R_OB = R_QB + (size_t)M_PAD * D * 2, R_KB = R_OB + (size_t)M_PAD * D * 2, R_VT = R_KB + (size_t)KR_PAD * D * 2,
                 R_VTS = R_VT + (size_t)NB * NH * HDIM * LPP * 2, R_QIB = R_VTS + (size_t)DB * NH * HDIM * LSP * 2, R_KIB = R_QIB + (size_t)M_PAD * 512 * 2,
                 R_WIB = R_KIB + (size_t)KR_PAD * IDXD * 2, R_MASK = R_WIB + (size_t)M_PAD * 8 * 4,
                 MASK_S0 = (size_t)NB * NKB_P * LP * 2  , R_THR = al256(R_MASK + (MASK_S0 + (size_t)DB * NKB_S * DSEQ * 2) * 2 + 4096),
                 R_ATT_END = R_THR + (size_t)M_PAD * 4;
constexpr size_t R_G = WS_R1, R_U = R_G + (size_t)M_PAD * DFF * 2, R_H = R_U + (size_t)M_PAD * DFF * 2, R_FFN_END = R_H + (size_t)M_PAD * DFF * 2;
constexpr size_t WS_BAR = al256(R_ATT_END > R_FFN_END ? R_ATT_END : R_FFN_END);
constexpr size_t WS_STATS = WS_BAR + 16384;
constexpr size_t WS_NEED = WS_STATS + (size_t)M_PAD * 8;

constexpr int LDS_PARAMS = 163840 - 256; constexpr int LDS_BYTES = LDS_PARAMS + 256;

struct Params {
  const float* in[23];
  float* out;
  unsigned char* ws;
};
enum { I_XP = 0, I_XS, I_CAK, I_CAV, I_CAIK, I_CBK, I_CBV, I_CONV, I_META, I_RELB, I_WAIN, I_WAOUT, I_WBIN, I_WBOUT, I_LN1G, I_LN1B, I_LN2G, I_LN2B, I_WG, I_WU, I_CW, I_CB, I_WD };


DI void store_params(const Params& P, unsigned char* lds) {
  if (threadIdx.x < 25) { const unsigned long long v = threadIdx.x < 23 ? (unsigned long long)P.in[threadIdx.x < 23 ? threadIdx.x : 0] : (threadIdx.x == 23 ? (unsigned long long)P.out : (unsigned long long)P.ws);
    ((unsigned long long*)(lds + LDS_PARAMS))[threadIdx.x] = v; }
  __syncthreads();
}
DI unsigned long long lds_u64(const unsigned char* lds, int i) {
  const volatile unsigned* p = (const volatile unsigned*)(lds + LDS_PARAMS) + 2 * i; const unsigned lo = __builtin_amdgcn_readfirstlane(p[0]), hi = __builtin_amdgcn_readfirstlane(p[1]);
  return ((unsigned long long)hi << 32) | lo;
}
DI Params load_params(const unsigned char* lds) {
  Params Q;
#pragma unroll
  for (int i = 0; i < 23; ++i) Q.in[i] = (const float*)lds_u64(lds, i);
  Q.out = (float*)lds_u64(lds, 23); Q.ws = (unsigned char*)lds_u64(lds, 24); return Q;
}
DI unsigned pk2(float lo, float hi) { f32x2 v = {lo, hi}; return __builtin_bit_cast(unsigned, __builtin_convertvector(v, bf2_t)); }
DI bf16x8 pk8(float a0, float a1, float a2, float a3, float a4, float a5, float a6, float a7) {
  u32x4 p = {pk2(a0, a1), pk2(a2, a3), pk2(a4, a5), pk2(a6, a7)}; return __builtin_bit_cast(bf16x8, p); }
DI float bf2f(unsigned short b) { return __uint_as_float(((unsigned)b) << 16); }
DI int pi_row(int i) { return 16 * ((i >> 2) & 1) + 4 * (i >> 3) + (i & 3); }

DI int snake_item(int round, int b, int G) { return round * G + ((round & 1) ? (G - 1 - b) : b); }

struct Entry { int Tq, L, qrow0, krow0, qpos0, pitch; size_t vt_off  , mask_off; bool samp; };
DI Entry get_entry(int e) {
  Entry E;
  if (e < NB) { E.Tq = LP; E.L = LP; E.qrow0 = e * LP; E.krow0 = e * LP; E.qpos0 = 0; E.pitch = LPP; E.vt_off = (size_t)e * NH * HDIM * LPP; E.mask_off = (size_t)e * NKB_P * LP * 2; E.samp = false; }
  else { const int sb = e - NB; E.Tq = DSEQ; E.L = LS; E.qrow0 = M_P + sb * DSEQ; E.krow0 = M_P + sb * LS; E.qpos0 = PAST; E.pitch = LSP; E.vt_off = (size_t)sb * NH * HDIM * LSP; E.mask_off = MASK_S0 + (size_t)sb * NKB_S * DSEQ * 2; E.samp = true; }
  return E;
}
DI int vis_end(bool samp, int tq) { return samp ? LS : (tq < NMETA ? NMETA : NMETA + 64 * (((tq - NMETA) >> 6) + 1)); }
DI int rel_bucket(int rel) {
  const int n = rel < 0 ? -rel : rel; int b;
  if (n < 8) b = n; else if (n < 12) b = 8; else if (n < 16) b = 9; else if (n < 23) b = 10; else if (n < 32) b = 11; else if (n < 46) b = 12; else if (n < 64) b = 13; else if (n < 91) b = 14; else b = 15;
  return b + (rel > 0 ? 16 : 0);
}
#define XB_TMO      128
#define XB_XCNT(j)  (256  + 64 * (j))
#define XB_XSUB(j)  (1280 + 64 * (j))
#define XB_XGEN(j)  (2304 + 64 * (j))
#define XB_TOP      3328
#define XB_TOPGEN   3392
#define XCD_BAR_WORDS 3456
#define XB_SPIN_CAP (1u << 18)

__device__ __forceinline__ unsigned xb_ld(unsigned* p)              { return __hip_atomic_load(p, __ATOMIC_RELAXED, __HIP_MEMORY_SCOPE_AGENT); }
__device__ __forceinline__ unsigned xb_add(unsigned* p, unsigned v) { return __hip_atomic_fetch_add(p, v, __ATOMIC_RELAXED, __HIP_MEMORY_SCOPE_AGENT); }
__device__ __forceinline__ unsigned xb_xcc_id() { return (unsigned)__builtin_amdgcn_s_getreg((3 << 11) | 20) & 0xFu; }
#define XB_SPIN(cond, bar) do { unsigned _sp = 0; while (cond) { __builtin_amdgcn_s_sleep(1); \
    if ((++_sp & 255u) == 0u) { if (xb_ld(&(bar)[XB_TMO])) break; if (_sp > XB_SPIN_CAP) { atomicAdd(&(bar)[XB_TMO], 1u); break; } } } } while (0)

struct XcdBarrier {
    unsigned* bar; unsigned x;
    volatile LAS unsigned* st;
};

__device__ __forceinline__ XcdBarrier xcd_barrier_post(unsigned* bar, volatile LAS unsigned* st) {
    XcdBarrier b; b.bar = bar; b.x = xb_xcc_id(); b.st = st;
    if (threadIdx.x == 0) (void)xb_add(&bar[XB_XCNT(b.x)], 1u);
    return b;
}
__device__ __forceinline__ void xcd_barrier_complete(unsigned* bar, unsigned x, unsigned& nloc, unsigned& nx) {
    const unsigned G = gridDim.x * gridDim.y * gridDim.z;
    unsigned sum, cnt, mine, sp = 0u;
    for (;;) {
        sum = 0u; cnt = 0u; mine = 0u;
#pragma unroll
        for (unsigned j = 0; j < 16; ++j) { const unsigned c = xb_ld(&bar[XB_XCNT(j)]); sum += c; cnt += (c > 0u) ? 1u : 0u; mine = (j == x) ? c : mine; }
        if (sum == G) break;
        __builtin_amdgcn_s_sleep(1);
        if ((++sp & 255u) == 0u) { if (xb_ld(&bar[XB_TMO])) break; if (sp > XB_SPIN_CAP) { atomicAdd(&bar[XB_TMO], 1u); break; } }
    }
    nloc = mine > 0u ? mine : 1u; nx = cnt > 0u ? cnt : 1u;
}

__device__ __forceinline__ void xcd_barrier(const XcdBarrier& b) {
    asm volatile("s_waitcnt vmcnt(0)" ::: "memory");
    __syncthreads();
    if (threadIdx.x == 0) {
        unsigned* bar = b.bar;
        __builtin_amdgcn_s_waitcnt(0);
        unsigned nloc = b.st[0], nx = b.st[1];
        if (nloc == 0u) { xcd_barrier_complete(bar, b.x, nloc, nx); b.st[0] = nloc; b.st[1] = nx; }
        const unsigned old = xb_add(&bar[XB_XSUB(b.x)], 1u);
        const unsigned gen = old / nloc;
        if (old + 1u == (gen + 1u) * nloc) {
            __builtin_amdgcn_fence(__ATOMIC_RELEASE, "agent");
            asm volatile("s_waitcnt vmcnt(0)" ::: "memory");
            const unsigned og = xb_add(&bar[XB_TOP], 1u);
            const unsigned tg = og / nx;
            if (og + 1u == (tg + 1u) * nx) xb_add(&bar[XB_TOPGEN], 1u);
            else XB_SPIN(xb_ld(&bar[XB_TOPGEN]) == tg, bar);
            __builtin_amdgcn_fence(__ATOMIC_ACQUIRE, "agent");
            xb_add(&bar[XB_XGEN(b.x)], 1u);
            asm volatile("s_waitcnt vmcnt(0)" ::: "memory");
        } else {
            XB_SPIN(xb_ld(&bar[XB_XGEN(b.x)]) == gen, bar);
            __builtin_amdgcn_fence(__ATOMIC_ACQUIRE, "agent");
            asm volatile("s_waitcnt vmcnt(0)" ::: "memory");
        }
    }
    __syncthreads();
}


DI void wjob(const Params& P, int job, const float*& src, int& K, int& N, bf16_t*& dst) {
  if (job < 2) { src = P.in[I_WAIN] + (size_t)job * D * A_IN; K = D; N = A_IN; dst = (bf16_t*)(P.ws + W_AIN) + (size_t)job * A_IN_PAD * D; }
  else if (job < 4) { const int j = job - 2; src = P.in[I_WAOUT] + (size_t)j * D * D; K = D; N = D; dst = (bf16_t*)(P.ws + W_AOUT) + (size_t)j * D * D; }
  else if (job < 6) { const int j = job - 4; src = P.in[I_WBIN] + (size_t)j * D * B_IN; K = D; N = B_IN; dst = (bf16_t*)(P.ws + W_BIN) + (size_t)j * B_IN * D; }
  else if (job < 8) { const int j = job - 6; src = P.in[I_WBOUT] + (size_t)j * D * D; K = D; N = D; dst = (bf16_t*)(P.ws + W_BOUT) + (size_t)j * D * D; }
  else if (job < 12) { const int l = job - 8; src = P.in[I_WG] + (size_t)l * D * DFF; K = D; N = DFF; dst = (bf16_t*)(P.ws + W_FFN1) + (size_t)l * 2 * DFF * D; }
  else if (job < 16) { const int l = job - 12; src = P.in[I_WU] + (size_t)l * D * DFF; K = D; N = DFF; dst = (bf16_t*)(P.ws + W_FFN1) + (size_t)l * 2 * DFF * D + (size_t)DFF * D; }
  else { const int l = job - 16; src = P.in[I_WD] + (size_t)l * DFF * D; K = DFF; N = D; dst = (bf16_t*)(P.ws + W_FFN2) + (size_t)l * D * DFF; }
}
struct TrTile { const float* src; size_t spitch; int nlim; bf16_t* dst; size_t dpitch; };
DI void tr_load(float (&v)[8], const TrTile& t, int tid) {
#pragma unroll
  for (int i = 0; i < 8; ++i) { const int kk = (tid >> 6) + 8 * i, nn = tid & 63; v[i] = nn < t.nlim ? t.src[(size_t)kk * t.spitch + nn] : 0.f; }
}
template <class F> DI void tr_loop(int ntiles, F info, float* tl  ) {
  const int tid = ltid(); float v[8]; int T = blockIdx.x; TrTile cur{}, nxt{};
  if (T < ntiles) { cur = info(T); tr_load(v, cur, tid); }
  for (; T < ntiles; T += gridDim.x) {
#pragma unroll
    for (int i = 0; i < 8; ++i) { const int kk = (tid >> 6) + 8 * i, nn = tid & 63; tl[nn * 65 + kk] = v[i]; }
    const int Tn = T + gridDim.x;
    if (Tn < ntiles) { nxt = info(Tn); tr_load(v, nxt, tid); }
    __syncthreads();
#pragma unroll
    for (int i = 0; i < 4; ++i) { const int nn = (tid >> 5) + 16 * i, kk = 2 * (tid & 31); *(unsigned*)(cur.dst + (size_t)nn * cur.dpitch + kk) = pk2(tl[nn * 65 + kk], tl[nn * 65 + kk + 1]); }
    __syncthreads();
    cur = nxt;
  }
}
DI void phase0(const Params& P, unsigned char* lds) {
  float* tl = (float*)lds;
  tr_loop(12864, [&](int T) {
    int job, t;
    if (T < 1856) { job = T / 928; t = T - job * 928; }
    else if (T < 2368) { job = 2 + (T - 1856) / 256; t = (T - 1856) & 255; }
    else if (T < 3904) { job = 4 + (T - 2368) / 768; t = (T - 2368) % 768; }
    else if (T < 4416) { job = 6 + (T - 3904) / 256; t = (T - 3904) & 255; }
    else { job = 8 + (T - 4416) / 704; t = (T - 4416) % 704; }
    const float* src; int K, N; bf16_t* dst; wjob(P, job, src, K, N, dst);
    const int ntn = (N + 63) >> 6, tk = t / ntn, tn = t - tk * ntn;
    return TrTile{src + (size_t)tk * 64 * N + tn * 64, (size_t)N, N - tn * 64, dst + (size_t)tn * 64 * K + tk * 64, (size_t)K};
  }, tl);
  float* X = (float*)(P.ws + WS_X); bf16_t* XB = (bf16_t*)(P.ws + WS_XB);
  const size_t nth = (size_t)gridDim.x * 512, gt = (size_t)blockIdx.x * 512 + ltid();
  for (size_t i0 = gt; i0 < (size_t)M_ALL * 256; i0 += 4 * nth) {
    f32x4 v[4]; size_t dsti[4]; bool ok[4];
#pragma unroll
    for (int k = 0; k < 4; ++k) { const size_t i = i0 + (size_t)k * nth; ok[k] = i < (size_t)M_ALL * 256; const size_t ic = ok[k] ? i : 0;
      const int row = (int)(ic >> 8), c4 = (int)(ic & 255); const float* sp;
      if (row < M_P) { const int b = row / LP, t = row - b * LP; sp = t < NMETA ? P.in[I_META] + (size_t)t * D : P.in[I_XP] + ((size_t)b * SEQ + (t - NMETA)) * D; }
      else sp = P.in[I_XS] + (size_t)(row - M_P) * D;
      v[k] = *(const f32x4*)(sp + 4 * c4); dsti[k] = (size_t)row * D + 4 * c4; }
#pragma unroll
    for (int k = 0; k < 4; ++k) if (ok[k]) { *(f32x4*)(X + dsti[k]) = v[k]; u32x2 pk = {pk2(v[k][0], v[k][1]), pk2(v[k][2], v[k][3])}; *(u32x2*)(XB + dsti[k]) = pk; }
  }
}
DI void cache_phase(const Params& P, unsigned char* lds, bool isA, int j) {
  const float* ck = (isA ? P.in[I_CAK] : P.in[I_CBK]) + (size_t)j * DB * PAST * D;
  const float* cv = (isA ? P.in[I_CAV] : P.in[I_CBV]) + (size_t)j * DB * PAST * D;
  bf16_t* KB = (bf16_t*)(P.ws + R_KB); bf16_t* VTS = (bf16_t*)(P.ws + R_VTS); bf16_t* KIB = (bf16_t*)(P.ws + R_KIB);
  const size_t nth = (size_t)gridDim.x * 512, gt = (size_t)blockIdx.x * 512 + ltid();
  for (size_t i0 = gt; i0 < (size_t)DB * PAST * 256; i0 += 4 * nth) {
    f32x4 v[4];
#pragma unroll
    for (int k = 0; k < 4; ++k) { const size_t i = i0 + (size_t)k * nth; v[k] = *(const f32x4*)(ck + (i < (size_t)DB * PAST * 256 ? i : 0) * 4); }
#pragma unroll
    for (int k = 0; k < 4; ++k) { const size_t i = i0 + (size_t)k * nth; if (i >= (size_t)DB * PAST * 256) break;
      const int c4 = (int)(i & 255); const int rp = (int)(i >> 8); const int sb = rp >> 11, pos = rp & 2047;
      u32x2 pk = {pk2(v[k][0], v[k][1]), pk2(v[k][2], v[k][3])}; *(u32x2*)(KB + (size_t)(M_P + sb * LS + pos) * D + 4 * c4) = pk; }
  }
  if (isA) {
    const float* cik = P.in[I_CAIK] + (size_t)j * DB * PAST * IDXD;
    for (size_t i = gt; i < (size_t)DB * PAST * 16; i += nth) {
      const int c4 = (int)(i & 15); const int rp = (int)(i >> 4); const int sb = rp >> 11, pos = rp & 2047;
      const f32x4 v = *(const f32x4*)(cik + (size_t)rp * IDXD + 4 * c4);
      u32x2 pk = {pk2(v[0], v[1]), pk2(v[2], v[3])}; *(u32x2*)(KIB + (size_t)(M_P + sb * LS + pos) * IDXD + 4 * c4) = pk;
    }
  }
  float* tl = (float*)lds;
  tr_loop(DB * NH * 32 * 2, [&](int t) {
    const int dt = t & 1, pt = (t >> 1) & 31, head = (t >> 6) & 7, sb = t >> 9;
    return TrTile{cv + ((size_t)sb * PAST + pt * 64) * D + head * HDIM + dt * 64, (size_t)D, 64, VTS + ((size_t)(sb * NH + head) * HDIM + dt * 64) * LSP + pt * 64, (size_t)LSP};
  }, tl);
}
struct EpiInProj {
  static constexpr bool PERM = true, AFTER_DRAIN = false;
  int isA, j; float* out; unsigned char* ws;
  __device__ __forceinline__ void operator()(const f32x4 (&acc)[2][2][4][2], const pg8::Unit& u, int wr, int wc, int fr, int fq) const {
    const int pn = u.pn; const int sec = pn >> 2;
    bf16_t* QB = (bf16_t*)(ws + R_QB); bf16_t* KB = (bf16_t*)(ws + R_KB); bf16_t* VT = (bf16_t*)(ws + R_VT); bf16_t* VTS = (bf16_t*)(ws + R_VTS);
    bf16_t* QIB = (bf16_t*)(ws + R_QIB); bf16_t* KIB = (bf16_t*)(ws + R_KIB); float* WIB = (float*)(ws + R_WIB);
#pragma unroll
    for (int ai = 0; ai < 2; ++ai)
#pragma unroll
      for (int m = 0; m < 4; ++m) {
        const int row = u.pm * 256 + ai * 128 + wr * 64 + m * 16 + fr;
        if (row >= M_ALL) continue;
        const bool samp = row >= M_P; const int srow = row - M_P;
        const int b = samp ? (srow >> 4) : row / LP; const int t = samp ? (srow & 15) : row - b * LP;
        const int krow = samp ? M_P + b * LS + PAST + t : row;
#pragma unroll
        for (int bj = 0; bj < 2; ++bj) {
          const int col = pn * 256 + bj * 128 + wc * 32 + 8 * fq; const f32x4 v0 = acc[ai][bj][m][0], v1 = acc[ai][bj][m][1];
          if (sec == 0) { const float qs = isA ? QSCALE * LOG2E : QSCALE; u32x4 pk = {pk2(v0[0] * qs, v0[1] * qs), pk2(v0[2] * qs, v0[3] * qs), pk2(v1[0] * qs, v1[1] * qs), pk2(v1[2] * qs, v1[3] * qs)}; *(u32x4*)(QB + (size_t)row * D + col) = pk; }
          else if (sec == 1) { const int c = col - D;
            float* o = samp ? out + (isA ? O_AKS : O_BKS) + (size_t)j * M_S * D + (size_t)srow * D + c : out + (isA ? O_AKP : O_BKP) + (size_t)j * M_P * D + (size_t)row * D + c;
            *(f32x4*)o = v0; *(f32x4*)(o + 4) = v1; u32x4 pk = {pk2(v0[0], v0[1]), pk2(v0[2], v0[3]), pk2(v1[0], v1[1]), pk2(v1[2], v1[3])}; *(u32x4*)(KB + (size_t)krow * D + c) = pk; }
          else if (sec == 2) { const int c = col - 2 * D;
            float* o = samp ? out + (isA ? O_AVS : O_BVS) + (size_t)j * M_S * D + (size_t)srow * D + c : out + (isA ? O_AVP : O_BVP) + (size_t)j * M_P * D + (size_t)row * D + c;
            *(f32x4*)o = v0; *(f32x4*)(o + 4) = v1; const int head = c >> 7, d = c & 127;
            bf16_t* vt = samp ? VTS + ((size_t)(b * NH + head) * HDIM + d) * LSP + PAST + t : VT + ((size_t)(b * NH + head) * HDIM + d) * LPP + t;
            const int pitch = samp ? LSP : LPP; const unsigned p01 = pk2(v0[0], v0[1]), p23 = pk2(v0[2], v0[3]), p45 = pk2(v1[0], v1[1]), p67 = pk2(v1[2], v1[3]);
            vt[0] = (bf16_t)(p01 & 0xffff); vt[pitch] = (bf16_t)(p01 >> 16); vt[2 * pitch] = (bf16_t)(p23 & 0xffff); vt[3 * pitch] = (bf16_t)(p23 >> 16);
            vt[4 * pitch] = (bf16_t)(p45 & 0xffff); vt[5 * pitch] = (bf16_t)(p45 >> 16); vt[6 * pitch] = (bf16_t)(p67 & 0xffff); vt[7 * pitch] = (bf16_t)(p67 >> 16); }
          else { const int c = col - 3 * D;
            if (c < 512) { u32x4 pk = {pk2(v0[0], v0[1]), pk2(v0[2], v0[3]), pk2(v1[0], v1[1]), pk2(v1[2], v1[3])}; *(u32x4*)(QIB + (size_t)row * 512 + c) = pk; }
            else if (c < 576) { const int cc = c - 512;
              float* o = samp ? out + O_AIKS + (size_t)j * M_S * IDXD + (size_t)srow * IDXD + cc : out + O_AIKP + (size_t)j * M_P * IDXD + (size_t)row * IDXD + cc;
              *(f32x4*)o = v0; *(f32x4*)(o + 4) = v1; u32x4 pk = {pk2(v0[0], v0[1]), pk2(v0[2], v0[3]), pk2(v1[0], v1[1]), pk2(v1[2], v1[3])}; *(u32x4*)(KIB + (size_t)krow * IDXD + cc) = pk; }
            else if (c < 584) { f32x4 w0 = {v0[0] * WISCALE, v0[1] * WISCALE, v0[2] * WISCALE, v0[3] * WISCALE}, w1 = {v1[0] * WISCALE, v1[1] * WISCALE, v1[2] * WISCALE, v1[3] * WISCALE};
              *(f32x4*)(WIB + (size_t)row * 8) = w0; *(f32x4*)(WIB + (size_t)row * 8 + 4) = w1; }
          }
        }
      }
  }
  __device__ __forceinline__ void st(int row, int col, const f32x4& v) const {
    bf16_t* QB = (bf16_t*)(ws + R_QB); bf16_t* KB = (bf16_t*)(ws + R_KB); bf16_t* VT = (bf16_t*)(ws + R_VT); bf16_t* VTS = (bf16_t*)(ws + R_VTS);
    bf16_t* QIB = (bf16_t*)(ws + R_QIB); bf16_t* KIB = (bf16_t*)(ws + R_KIB); float* WIB = (float*)(ws + R_WIB);
    const int sec = col >> 10;
    const bool samp = row >= M_P; const int srow = row - M_P;
    const int b = samp ? (srow >> 4) : row / LP; const int t = samp ? (srow & 15) : row - b * LP;
    const int krow = samp ? M_P + b * LS + PAST + t : row;
    if (sec == 0) { const float qs = isA ? QSCALE * LOG2E : QSCALE; u32x2 pk = {pk2(v[0] * qs, v[1] * qs), pk2(v[2] * qs, v[3] * qs)}; *(u32x2*)(QB + (size_t)row * D + col) = pk; }
    else if (sec == 1) { const int c = col - D;
      float* o = samp ? out + (isA ? O_AKS : O_BKS) + (size_t)j * M_S * D + (size_t)srow * D + c : out + (isA ? O_AKP : O_BKP) + (size_t)j * M_P * D + (size_t)row * D + c;
      *(f32x4*)o = v; u32x2 pk = {pk2(v[0], v[1]), pk2(v[2], v[3])}; *(u32x2*)(KB + (size_t)krow * D + c) = pk; }
    else if (sec == 2) { const int c = col - 2 * D;
      float* o = samp ? out + (isA ? O_AVS : O_BVS) + (size_t)j * M_S * D + (size_t)srow * D + c : out + (isA ? O_AVP : O_BVP) + (size_t)j * M_P * D + (size_t)row * D + c;
      *(f32x4*)o = v; const int head = c >> 7, d = c & 127;
      bf16_t* vt = samp ? VTS + ((size_t)(b * NH + head) * HDIM + d) * LSP + PAST + t : VT + ((size_t)(b * NH + head) * HDIM + d) * LPP + t;
      const int pitch = samp ? LSP : LPP; const unsigned p01 = pk2(v[0], v[1]), p23 = pk2(v[2], v[3]);
      vt[0] = (bf16_t)(p01 & 0xffff); vt[pitch] = (bf16_t)(p01 >> 16); vt[2 * pitch] = (bf16_t)(p23 & 0xffff); vt[3 * pitch] = (bf16_t)(p23 >> 16); }
    else if (isA) { const int c = col - 3 * D;
      if (c < 512) { u32x2 pk = {pk2(v[0], v[1]), pk2(v[2], v[3])}; *(u32x2*)(QIB + (size_t)row * 512 + c) = pk; }
      else if (c < 576) { const int cc = c - 512;
        float* o = samp ? out + O_AIKS + (size_t)j * M_S * IDXD + (size_t)srow * IDXD + cc : out + O_AIKP + (size_t)j * M_P * IDXD + (size_t)row * IDXD + cc;
        *(f32x4*)o = v; u32x2 pk = {pk2(v[0], v[1]), pk2(v[2], v[3])}; *(u32x2*)(KIB + (size_t)krow * IDXD + cc) = pk; }
      else if (c < 584) { f32x4 wv = {v[0] * WISCALE, v[1] * WISCALE, v[2] * WISCALE, v[3] * WISCALE}; *(f32x4*)(WIB + (size_t)row * 8 + (c - 576)) = wv; }
    }
  }
};
struct EpiResid {
  static constexpr bool PERM = true, AFTER_DRAIN = false;
  float* X; const float* stats; const float* g; const float* b; int noln;
  __device__ __forceinline__ void operator()(const f32x4 (&acc)[2][2][4][2], const pg8::Unit& u, int wr, int wc, int fr, int fq) const {
#pragma unroll
    for (int bj = 0; bj < 2; ++bj) {
      const int col = u.pn * 256 + bj * 128 + wc * 32 + 8 * fq;
      f32x4 gv0 = {1.f, 1.f, 1.f, 1.f}, gv1 = gv0, bv0 = {0.f, 0.f, 0.f, 0.f}, bv1 = bv0;
      if (!noln) { gv0 = *(const f32x4*)(g + col); gv1 = *(const f32x4*)(g + col + 4); bv0 = *(const f32x4*)(b + col); bv1 = *(const f32x4*)(b + col + 4); }
#pragma unroll
      for (int ai = 0; ai < 2; ++ai)
#pragma unroll
        for (int m = 0; m < 4; ++m) {
          const int row = u.pm * 256 + ai * 128 + wr * 64 + m * 16 + fr;
          if (row >= M_ALL) continue;
          float mu = 0.f, rs = 1.f;
          if (!noln) { const f32x2 st2 = *(const f32x2*)(stats + 2 * (size_t)row); mu = st2[0]; rs = st2[1]; }
          float* p = X + (size_t)row * D + col; const f32x4 x0 = *(const f32x4*)p, x1 = *(const f32x4*)(p + 4); const f32x4 v0 = acc[ai][bj][m][0], v1 = acc[ai][bj][m][1];
          const f32x4 n0 = (x0 - mu) * rs * gv0 + bv0, n1 = (x1 - mu) * rs * gv1 + bv1;
          f32x4 r0 = {ALPHA * n0[0] + v0[0], ALPHA * n0[1] + v0[1], ALPHA * n0[2] + v0[2], ALPHA * n0[3] + v0[3]}, r1 = {ALPHA * n1[0] + v1[0], ALPHA * n1[1] + v1[1], ALPHA * n1[2] + v1[2], ALPHA * n1[3] + v1[3]};
          *(f32x4*)p = r0; *(f32x4*)(p + 4) = r1;
        }
      __builtin_amdgcn_sched_barrier(0);
    }
  }
  __device__ __forceinline__ void st(int row, int col, const f32x4& v) const {
    f32x4 gv = {1.f, 1.f, 1.f, 1.f}, bv = {0.f, 0.f, 0.f, 0.f}; float mu = 0.f, rs = 1.f;
    if (!noln) { gv = *(const f32x4*)(g + col); bv = *(const f32x4*)(b + col); const f32x2 st2 = *(const f32x2*)(stats + 2 * (size_t)row); mu = st2[0]; rs = st2[1]; }
    float* p = X + (size_t)row * D + col; const f32x4 x = *(const f32x4*)p; const f32x4 xn = (x - mu) * rs * gv + bv;
    f32x4 r = {ALPHA * xn[0] + v[0], ALPHA * xn[1] + v[1], ALPHA * xn[2] + v[2], ALPHA * xn[3] + v[3]}; *(f32x4*)p = r;
  }
};
struct EpiFFN1 {
  static constexpr bool PERM = true, AFTER_DRAIN = false;
  int l; float* out; unsigned char* ws;
  __device__ __forceinline__ void operator()(const f32x4 (&acc)[2][2][4][2], const pg8::Unit& u, int wr, int wc, int fr, int fq) const {
    const bool gate = u.pn < 11; bf16_t* dst = (bf16_t*)(ws + (gate ? R_G : R_U));
#pragma unroll
    for (int ai = 0; ai < 2; ++ai)
#pragma unroll
      for (int m = 0; m < 4; ++m) {
        const int row = u.pm * 256 + ai * 128 + wr * 64 + m * 16 + fr;
        if (row >= M_ALL) continue;
        float* cst = nullptr;
        if (gate) {
          if (row >= M_P) { const int srow = row - M_P, sb = srow >> 4, t = srow & 15; if (t >= DSEQ - 2) cst = out + O_CONVS + ((size_t)(l * DB + sb) * 2 + (t - (DSEQ - 2))) * DFF; }
          else { const int b = row / LP, t = row - b * LP; if (t >= LP - 2) cst = out + O_CONVP + ((size_t)(l * NB + b) * 2 + (t - (LP - 2))) * DFF; }
        }
#pragma unroll
        for (int bj = 0; bj < 2; ++bj) {
          const int col = (gate ? u.pn : u.pn - 11) * 256 + bj * 128 + wc * 32 + 8 * fq; const f32x4 v0 = acc[ai][bj][m][0], v1 = acc[ai][bj][m][1];
          u32x4 pk = {pk2(v0[0], v0[1]), pk2(v0[2], v0[3]), pk2(v1[0], v1[1]), pk2(v1[2], v1[3])}; *(u32x4*)(dst + (size_t)row * DFF + col) = pk;
          if (cst) { *(f32x4*)(cst + col) = v0; *(f32x4*)(cst + col + 4) = v1; }
        }
      }
  }
  __device__ __forceinline__ void st(int row, int col, const f32x4& v) const {
    const bool gate = col < DFF; bf16_t* dst = (bf16_t*)(ws + (gate ? R_G : R_U)); const int c = gate ? col : col - DFF;
    u32x2 pk = {pk2(v[0], v[1]), pk2(v[2], v[3])}; *(u32x2*)(dst + (size_t)row * DFF + c) = pk;
    if (gate) {
      if (row >= M_P) { const int srow = row - M_P, sb = srow >> 4, t = srow & 15; if (t >= DSEQ - 2) *(f32x4*)(out + O_CONVS + ((size_t)(l * DB + sb) * 2 + (t - (DSEQ - 2))) * DFF + c) = v; }
      else { const int b = row / LP, t = row - b * LP; if (t >= LP - 2) *(f32x4*)(out + O_CONVP + ((size_t)(l * NB + b) * 2 + (t - (LP - 2))) * DFF + c) = v; }
    }
  }
};
template <class Epi> DI void run_gemm(unsigned char* lds, const bf16_t* A, const bf16_t* Bt, int M, int N, int K, const Epi& E) {
  pg8::Gemm g{A, Bt, M, N, K}; pg8::StaticOrder S; S.init(M, N, (int)gridDim.x, (int)blockIdx.x);
  pg8::gemm_phase<Epi, pg8::StaticOrder, false>((LAS unsigned char*)lds, g, S, E, nullptr);
}
DI int next_item(unsigned* ctr, unsigned char* lds) {
  volatile unsigned* slot = (volatile unsigned*)(lds + LDS_PARAMS + 216);
  __syncthreads();
  if (threadIdx.x == 0) *slot = __hip_atomic_fetch_add(ctr, 1u, __ATOMIC_RELAXED, __HIP_MEMORY_SCOPE_AGENT);
  __syncthreads();
  return (int)*slot;
}
template <class Epi> DI void tail_gemm(unsigned char* lds, const bf16_t* A, const bf16_t* Bt, int N, int K, const Epi& E, unsigned* ctr) {
  const int tid = ltid(), w = tid >> 6, lane = tid & 63, n = lane & 31, h = lane >> 5;
  const int ntn = (N + 31) >> 5, ntiles = 6 * ntn, kw = K >> 3;
  float* red = (float*)lds;
  for (;;) {
    const int t = next_item(ctr, lds); if (t >= ntiles) break;
    const int nt = t / 6, mt = t - nt * 6;
    const bf16_t* ap = A + (size_t)(M_MAIN + 32 * mt + n) * K + w * kw + 8 * h;
    const bf16_t* bp = Bt + (size_t)(32 * nt + n) * K + w * kw + 8 * h;
    f32x16 acc;
#pragma unroll
    for (int r = 0; r < 16; ++r) acc[r] = 0.f;
#pragma unroll 2
    for (int k0 = 0; k0 < kw; k0 += 32) {
      const bf16x8 a0 = *(const bf16x8*)(bp + k0), a1 = *(const bf16x8*)(bp + k0 + 16), b0 = *(const bf16x8*)(ap + k0), b1 = *(const bf16x8*)(ap + k0 + 16);
      acc = MFMA32(a0, b0, acc); acc = MFMA32(a1, b1, acc);
    }
#pragma unroll
    for (int r = 0; r < 16; ++r) red[(w * 16 + r) * 64 + lane] = acc[r];
    __syncthreads();
    if (w < 4) {
      f32x4 v = {0.f, 0.f, 0.f, 0.f};
#pragma unroll
      for (int ww = 0; ww < 8; ++ww)
#pragma unroll
        for (int i = 0; i < 4; ++i) v[i] += red[(ww * 16 + 4 * w + i) * 64 + lane];
      E.st(M_MAIN + 32 * mt + n, 32 * nt + 8 * w + 4 * h, v);
    }
    __syncthreads();
  }
}
DI float wave_sum(float v) {
#pragma unroll
  for (int o = 32; o >= 1; o >>= 1) v += __shfl_xor(v, o);
  return v;
}
DI void ln_phase(const Params& P, const float* __restrict__ g, const float* __restrict__ be, bool fin) {
  float* X = (float*)(P.ws + WS_X); bf16_t* XB = (bf16_t*)(P.ws + WS_XB); float* STATS = (float*)(P.ws + WS_STATS);
  const int tid = ltid(), lane = tid & 63, w = tid >> 6;
  f32x4 gv[4], bv[4];
#pragma unroll
  for (int i = 0; i < 4; ++i) { gv[i] = *(const f32x4*)(g + 4 * (i * 64 + lane)); bv[i] = *(const f32x4*)(be + 4 * (i * 64 + lane)); }
  const int GW = gridDim.x * 8;
  for (int row0 = blockIdx.x * 8 + w; row0 < M_ALL; row0 += 2 * GW) {
    f32x4 v[2][4];
#pragma unroll
    for (int k = 0; k < 2; ++k) { const int row = min(row0 + k * GW, M_ALL - 1);
#pragma unroll
      for (int i = 0; i < 4; ++i) v[k][i] = *(const f32x4*)(X + (size_t)row * D + 4 * (i * 64 + lane)); }
#pragma unroll
    for (int k = 0; k < 2; ++k) {
      const int row = row0 + k * GW; if (row >= M_ALL) break;
      float s = 0.f;
#pragma unroll
      for (int i = 0; i < 4; ++i) s += v[k][i][0] + v[k][i][1] + v[k][i][2] + v[k][i][3];
      const float mu = wave_sum(s) * (1.f / D); float q = 0.f;
#pragma unroll
      for (int i = 0; i < 4; ++i) { v[k][i] -= mu; q += v[k][i][0] * v[k][i][0] + v[k][i][1] * v[k][i][1] + v[k][i][2] * v[k][i][2] + v[k][i][3] * v[k][i][3]; }
      const float rstd = rsqrtf(wave_sum(q) * (1.f / D) + LN_EPS);
      float* yo = nullptr;
      if (fin) { if (row >= M_P) yo = P.out + O_YS + (size_t)(row - M_P) * D; else { const int b = row / LP, t = row - b * LP; if (t >= NMETA) yo = P.out + O_YP + ((size_t)b * SEQ + (t - NMETA)) * D; } }
#pragma unroll
      for (int i = 0; i < 4; ++i) { const f32x4 y = v[k][i] * rstd * gv[i] + bv[i]; const int c = 4 * (i * 64 + lane);
        if (!fin) { u32x2 pk = {pk2(y[0], y[1]), pk2(y[2], y[3])}; *(u32x2*)(XB + (size_t)row * D + c) = pk; } if (yo) *(f32x4*)(yo + c) = y; }
      if (!fin && lane == 0) { f32x2 st = {mu, rstd}; *(f32x2*)(STATS + 2 * (size_t)row) = st; }
    }
  }
}
DI float gelu_tanh(float x) { const float y = 0.7978845608028654f * (x + 0.044715f * x * x * x); return x * __builtin_amdgcn_rcpf(1.f + __expf(-2.f * y)); }
DI void conv_phase(const Params& P, int l) {
  const bf16_t* __restrict__ G = (const bf16_t*)(P.ws + R_G); const bf16_t* __restrict__ U = (const bf16_t*)(P.ws + R_U); bf16_t* __restrict__ H = (bf16_t*)(P.ws + R_H);
  const float* __restrict__ cw = P.in[I_CW] + (size_t)l * 3 * DFF; const float* __restrict__ cb = P.in[I_CB] + (size_t)l * DFF; const float* __restrict__ st = P.in[I_CONV] + (size_t)l * DB * 2 * DFF;
  constexpr int NCH = DFF / 8;
  const int nth = gridDim.x * 512, gt = blockIdx.x * 512 + ltid(), nrg = nth / NCH, rpg = (M_ALL + nrg - 1) / nrg;
  const int ch = gt % NCH, rg = gt / NCH, f0 = 8 * ch;
  const int rb = rg * rpg, re = min(rb + rpg, M_ALL);
  if (rg < nrg && rb < re) {
    float w0[8], w1[8], w2[8], bb[8];
#pragma unroll
    for (int e = 0; e < 8; ++e) { w0[e] = cw[f0 + e]; w1[e] = cw[DFF + f0 + e]; w2[e] = cw[2 * DFF + f0 + e]; bb[e] = cb[f0 + e]; }
    float p1[8], p2[8];
    { const bf16x8 a = *(const bf16x8*)(G + (size_t)max(rb - 1, 0) * DFF + f0), c = *(const bf16x8*)(G + (size_t)max(rb - 2, 0) * DFF + f0);
#pragma unroll
      for (int e = 0; e < 8; ++e) { p1[e] = bf2f((unsigned short)a[e]); p2[e] = bf2f((unsigned short)c[e]); } }
    for (int r0 = rb; r0 < re; r0 += 4) {
      bf16x8 gq[4], uq[4];
#pragma unroll
      for (int k = 0; k < 4; ++k) { const int r = min(r0 + k, re - 1); gq[k] = *(const bf16x8*)(G + (size_t)r * DFF + f0); uq[k] = *(const bf16x8*)(U + (size_t)r * DFF + f0); }
#pragma unroll
      for (int k = 0; k < 4; ++k) {
        const int r = r0 + k; if (r >= re) break;
        const bool samp = r >= M_P; const int sb = samp ? (r - M_P) >> 4 : 0; const int t = samp ? ((r - M_P) & 15) : r % LP;
        if (t < 2) {
#pragma unroll
          for (int e = 0; e < 8; ++e) { if (t == 0) p1[e] = samp ? st[((size_t)sb * 2 + 1) * DFF + f0 + e] : 0.f; p2[e] = samp ? st[((size_t)sb * 2 + t) * DFF + f0 + e] : 0.f; }
        }
        float hv[8], gc[8];
#pragma unroll
        for (int e = 0; e < 8; ++e) { gc[e] = bf2f((unsigned short)gq[k][e]); const float x = bb[e] + w0[e] * p2[e] + w1[e] * p1[e] + w2[e] * gc[e];
          hv[e] = gelu_tanh(x) * bf2f((unsigned short)uq[k][e]); p2[e] = p1[e]; p1[e] = gc[e]; }
        *(bf16x8*)(H + (size_t)r * DFF + f0) = pk8(hv[0], hv[1], hv[2], hv[3], hv[4], hv[5], hv[6], hv[7]);
      }
    }
  }
}
DI void idx_load(bf16x8 (&kf)[4], const bf16_t* kp) {
#pragma unroll
  for (int s = 0; s < 4; ++s) kf[s] = *(const bf16x8*)(kp + 16 * s);
}
DI void idx_chain(f32x16& acc, const bf16x8 (&kf)[4], const bf16x8 (&q)[4]) {
#pragma unroll
  for (int r = 0; r < 16; ++r) acc[r] = 0.f;
#pragma unroll
  for (int s = 0; s < 4; ++s) acc = MFMA32(kf[s], q[s], acc);
}
DI void idx_lds4(bf16x8 (&q)[4], const unsigned char* qlds, int hd) {
#pragma unroll
  for (int s = 0; s < 4; ++s) q[s] = *(const bf16x8*)(qlds + ((hd - 1) * 4 + s) * 1024);
}
DI void idx_absfma(f32x16& sc, const f32x16& acc, float hw) {
  { float a = sc[0]; asm volatile("s_nop 7\n\ts_nop 3\n\tv_fma_f32 %0, |%1|, %2, %0" : "+v"(a) : "v"(acc[0]), "v"(hw)); sc[0] = a; }
#pragma unroll
  for (int r = 1; r < 16; ++r) { float a = sc[r]; asm volatile("v_fma_f32 %0, |%1|, %2, %0" : "+v"(a) : "v"(acc[r]), "v"(hw)); sc[r] = a; }
}
#define SB0 __builtin_amdgcn_sched_barrier(0)
DI void idx_scores(f32x16& sc, const bf16x8 (&q0)[4], const bf16x8 (&qlin)[4], const unsigned char* qlds  , const float (&hw)[8], const bf16x8 (&kf)[4]) {
  f32x16 a, b; bf16x8 qa[4], qb[4];
  idx_chain(sc, kf, qlin); idx_chain(a, kf, q0); idx_lds4(qa, qlds, 1); idx_lds4(qb, qlds, 2); SB0;
  idx_chain(b, kf, qa); SB0; idx_absfma(sc, a, hw[0]); idx_lds4(qa, qlds, 3); SB0;
  idx_chain(a, kf, qb); SB0; idx_absfma(sc, b, hw[1]); idx_lds4(qb, qlds, 4); SB0;
  idx_chain(b, kf, qa); SB0; idx_absfma(sc, a, hw[2]); idx_lds4(qa, qlds, 5); SB0;
  idx_chain(a, kf, qb); SB0; idx_absfma(sc, b, hw[3]); idx_lds4(qb, qlds, 6); SB0;
  idx_chain(b, kf, qa); SB0; idx_absfma(sc, a, hw[4]); idx_lds4(qa, qlds, 7); SB0;
  idx_chain(a, kf, qb); SB0; idx_absfma(sc, b, hw[5]); SB0;
  idx_chain(b, kf, qa); SB0; idx_absfma(sc, a, hw[6]); SB0;
  idx_absfma(sc, b, hw[7]);
}
DI unsigned ord_key(float f) { const unsigned u = __float_as_uint(f); return (u & 0x80000000u) ? ~u : (u | 0x80000000u); }
constexpr int HROW = 1025;
constexpr int HIST_BYTES = 32 * HROW * 4 + 64;
DI void indexer_item(const Params& P, unsigned char* lds, int e, int g) {
  const Entry E = get_entry(e);
  const int tid = ltid(), w = tid >> 6, lane = tid & 63, n = lane & 31, h = lane >> 5;
  const int tq = 32 * g + n; const bool qvalid = tq < E.Tq; const int tqc = qvalid ? tq : E.Tq - 1;
  const int vend = qvalid ? vis_end(E.samp, tqc) : 0;
  const int tq_last = min(32 * g + 31, E.Tq - 1); const int vmax = vis_end(E.samp, tq_last); const int nblk = (vmax + 31) >> 5;
  const bf16_t* QIB = (const bf16_t*)(P.ws + R_QIB); const bf16_t* KIB = (const bf16_t*)(P.ws + R_KIB); const float* WIB = (const float*)(P.ws + R_WIB);
  unsigned short* MASK = (unsigned short*)(P.ws + R_MASK);
  bf16x8 q0[4];
  unsigned char* qlds_base = lds + HIST_BYTES + 256;
  { const bf16_t* qip = QIB + (size_t)(E.qrow0 + tqc) * 512 + 8 * h;
#pragma unroll
    for (int s = 0; s < 4; ++s) q0[s] = *(const bf16x8*)(qip + 16 * s);
#pragma unroll
    for (int i = 0; i < 4; ++i) { const int f = w + 8 * i;
      if (f < 28) *(bf16x8*)(qlds_base + f * 1024 + lane * 16) = *(const bf16x8*)(qip + ((f >> 2) + 1) * 64 + 16 * (f & 3)); } }
  const unsigned char* qlds = qlds_base + lane * 16;
  __syncthreads();
  float wi[8];
  { const f32x4 a = *(const f32x4*)(WIB + (size_t)(E.qrow0 + tqc) * 8), b = *(const f32x4*)(WIB + (size_t)(E.qrow0 + tqc) * 8 + 4);
    wi[0] = 0.5f * a[0]; wi[1] = 0.5f * a[1]; wi[2] = 0.5f * a[2]; wi[3] = 0.5f * a[3]; wi[4] = 0.5f * b[0]; wi[5] = 0.5f * b[1]; wi[6] = 0.5f * b[2]; wi[7] = 0.5f * b[3]; }
  bf16x8 qlin[4];
  { const bf16_t* qip = QIB + (size_t)(E.qrow0 + tqc) * 512 + 8 * h;
#pragma unroll
    for (int s = 0; s < 4; ++s) { float acc8[8];
#pragma unroll
      for (int k = 0; k < 8; ++k) acc8[k] = 0.f;
#pragma unroll
      for (int hd = 0; hd < 8; ++hd) { const bf16x8 v = *(const bf16x8*)(qip + hd * 64 + 16 * s);
#pragma unroll
        for (int k = 0; k < 8; ++k) acc8[k] += wi[hd] * bf2f((unsigned short)v[k]); }
      qlin[s] = pk8(acc8[0], acc8[1], acc8[2], acc8[3], acc8[4], acc8[5], acc8[6], acc8[7]); } }
  unsigned* hist = (unsigned*)lds; unsigned* pref = (unsigned*)(lds + HIST_BYTES); unsigned* krem = pref + 32;
  constexpr int CAP = 448;
  u32x2* clist = (u32x2*)lds; unsigned* selh = (unsigned*)(lds + 32 * CAP * 8);
  unsigned* ccnt = (unsigned*)(lds + HIST_BYTES + 256 + 28672); unsigned* selres = ccnt + 32;
  const bf16_t* kbase = KIB + (size_t)(E.krow0 + pi_row(n)) * IDXD + 8 * h;
  const bool selall = vend <= TOPK;
  const bool havehist = vmax > TOPK;
  if (havehist && tid < 32) { pref[tid] = 0u; krem[tid] = TOPK; }
  for (int p = 0;; ++p) {
    if (havehist) {
      const unsigned shift = p == 0 ? 21u : (p == 1 ? 10u : 0u), nbits = p == 2 ? 10u : 11u;
      const unsigned pshift = p == 0 ? 0u : (p == 1 ? 21u : 10u), pwidth = p == 0 ? 0u : 32u - pshift;
      for (int i = tid; i < HIST_BYTES / 16; i += 512) ((u32x4*)hist)[i] = (u32x4){0u, 0u, 0u, 0u};
      __syncthreads();
      const unsigned mypref = pref[n];
      const unsigned hrow_b = (unsigned)n * (HROW * 4);
      for (int blk = w; blk < nblk; blk += 8) {
        bf16x8 kf[4]; idx_load(kf, kbase + (size_t)blk * 32 * IDXD);
        f32x16 sc; idx_scores(sc, q0, qlin, qlds, wi, kf);
        const int lim = vend - (32 * blk + 16 * h);
#pragma unroll
        for (int r = 0; r < 16; ++r) {
          const unsigned u = __float_as_uint(sc[r]); const unsigned ok = u ^ ((unsigned)((int)u >> 31) | 0x80000000u);
          const unsigned d = __builtin_amdgcn_ubfe(ok, shift, nbits);
          const bool match = (r < lim) & (__builtin_amdgcn_ubfe(ok, pshift, pwidth) == mypref);
          const unsigned val = match ? (d & 1u) * 0xffffu + 1u : 0u;
          const unsigned addr = hrow_b + ((d << 1) & 0xffcu);
          __hip_atomic_fetch_add((unsigned*)(lds + addr), val, __ATOMIC_RELAXED, __HIP_MEMORY_SCOPE_WORKGROUP);
        }
      }
      __syncthreads();
      { const int q = tid >> 4, j = tid & 15, seg = 15 - j; const unsigned* hq = hist + q * HROW + seg * 64; const int rot = 4 * j;
        unsigned s = 0;
#pragma unroll 8
        for (int i = 0; i < 64; ++i) { const unsigned x = hq[(i + rot) & 63]; s += (x & 0xffffu) + (x >> 16); }
        unsigned incl = s;
#pragma unroll
        for (int off = 1; off < 16; off <<= 1) { const unsigned t = __shfl_up(incl, off, 16); if (j >= off) incl += t; }
        const unsigned above = incl - s, kr = krem[q], pold = pref[q];
        if (above < kr && kr <= above + s) {
          unsigned c = above; int bin = 0; unsigned newk = 1;
#pragma unroll 1
          for (int i = 63; i >= 0; --i) { const unsigned x = hq[i], hi = x >> 16, lo = x & 0xffffu;
            if (c + hi >= kr) { bin = 128 * seg + 2 * i + 1; newk = kr - c; break; } c += hi;
            if (c + lo >= kr) { bin = 128 * seg + 2 * i; newk = kr - c; break; } c += lo; }
          pref[q] = p == 0 ? (unsigned)bin : ((pold << (p == 1 ? 11 : 10)) | (unsigned)bin); krem[q] = newk;
        }
      }
      if (tid < 32) ccnt[tid] = 0u;
      __syncthreads();
    }
    const unsigned psh = (havehist && p < 2 && !selall) ? (p == 0 ? 21u : 10u) : 0u;
    const unsigned pl = (havehist && !selall) ? pref[n] : 0u;
    for (int blk = w; blk < nblk; blk += 8) {
      bf16x8 kf[4]; idx_load(kf, kbase + (size_t)blk * 32 * IDXD);
      f32x16 sc; idx_scores(sc, q0, qlin, qlds, wi, kf);
      const int lim = vend - (32 * blk + 16 * h);
      unsigned bits = 0u;
#pragma unroll
      for (int r = 0; r < 16; ++r) {
        const unsigned okp = ord_key(sc[r]) >> psh; const bool vis = r < lim;
        if (vis && (okp > pl || (okp == pl && psh == 0u))) bits |= 1u << r;
        if (vis && okp == pl && psh != 0u) {
          const unsigned slot = __hip_atomic_fetch_add(&ccnt[n], 1u, __ATOMIC_RELAXED, __HIP_MEMORY_SCOPE_WORKGROUP);
          if (slot < (unsigned)CAP) { u32x2 ent = {ord_key(sc[r]), (unsigned)(32 * blk + 16 * h + r)}; clist[n * CAP + slot] = ent; }
        }
      }
      if (qvalid) MASK[E.mask_off + ((size_t)blk * E.Tq + tq) * 2 + h] = (unsigned short)bits;
    }
    if (!havehist || p == 2) break;
    asm volatile("s_waitcnt vmcnt(0)" ::: "memory");
    __syncthreads();
    unsigned ovf = 0u;
#pragma unroll
    for (int i = 0; i < 32; i += 4) { const u32x4 c4 = *(const u32x4*)(ccnt + i); ovf |= (c4[0] > (unsigned)CAP) | (c4[1] > (unsigned)CAP) | (c4[2] > (unsigned)CAP) | (c4[3] > (unsigned)CAP); }
    if (ovf) continue;
    { const int q = tid >> 4, j = tid & 15, tqq = 32 * g + q;
      const bool active = tqq < E.Tq && vis_end(E.samp, min(tqq, E.Tq - 1)) > TOPK;
      const unsigned cnt = active ? ccnt[q] : 0u; unsigned need = krem[q];
      const int rem0 = p == 0 ? 21 : 10; const unsigned lowmask = (1u << rem0) - 1u;
      const u32x2* cl = clist + q * CAP; unsigned* sh = selh + q * 128; unsigned* MASK32 = (unsigned*)(P.ws + R_MASK) + (E.mask_off >> 1);
      unsigned selp = 0u, eqc = 0u;
      for (int rem = rem0; rem > 0;) {
        const int wd = rem < 7 ? rem : 7, shf = rem - wd;
#pragma unroll
        for (int i = 0; i < 8; ++i) sh[j * 8 + i] = 0u;
        __syncthreads();
#pragma unroll 1
        for (unsigned i = j; i < cnt; i += 16) { const unsigned low = cl[i][0] & lowmask; if ((low >> rem) == selp) __hip_atomic_fetch_add(&sh[(low >> shf) & ((1u << wd) - 1u)], 1u, __ATOMIC_RELAXED, __HIP_MEMORY_SCOPE_WORKGROUP); }
        __syncthreads();
        { const int seg = 15 - j; unsigned sseg = 0;
#pragma unroll
          for (int i = 0; i < 8; ++i) sseg += sh[8 * seg + i];
          unsigned incl = sseg;
#pragma unroll
          for (int off = 1; off < 16; off <<= 1) { const unsigned t = __shfl_up(incl, off, 16); if (j >= off) incl += t; }
          const unsigned above = incl - sseg;
          if (active && above < need && need <= above + sseg) {
            unsigned c = above;
            for (int i = 7; i >= 0; --i) { const unsigned x = sh[8 * seg + i]; if (c + x >= need) { selres[q * 3] = (unsigned)(8 * seg + i); selres[q * 3 + 1] = need - c; selres[q * 3 + 2] = x; break; } c += x; }
          }
        }
        __syncthreads();
        selp = (selp << wd) | selres[q * 3]; need = selres[q * 3 + 1]; eqc = selres[q * 3 + 2];
        rem = shf;
      }
#pragma unroll 1
      for (unsigned i = j; i < cnt; i += 16) {
        const u32x2 ent = cl[i]; const unsigned low = ent[0] & lowmask; bool take = low > selp;
        if (low == selp) {
          if (need >= eqc) take = true;
          else { unsigned rank = 0; for (unsigned k = 0; k < cnt; ++k) { const u32x2 o2 = cl[k]; rank += ((o2[0] & lowmask) == selp && o2[1] < ent[1]) ? 1u : 0u; } take = rank < need; }
        }
        if (take) atomicOr(MASK32 + (size_t)(ent[1] >> 5) * E.Tq + tqq, 1u << (ent[1] & 31u));
      }
    }
    break;
  }
  __syncthreads();
}
DI void indexer_phase(const Params& P, unsigned char* lds, int cidx) {
  constexpr int NIT = NB * 257 + DB;
  unsigned* ctr = (unsigned*)(P.ws + WS_BAR + 14336) + cidx;
  for (;;) {
    const int it = next_item(ctr, lds); if (it >= NIT) break;
    const bool pr = it < NB * 257; indexer_item(P, lds, pr ? (it & 3) : NB + (it - NB * 257), pr ? 256 - (it >> 2) : 0);
  }
}
constexpr int KT_K = 64 * 272 + 512, KT_V = 128 * 144, KT_STAGE = KT_K + KT_V;
DI void dsa_attn_item(const Params& P, unsigned char* lds, int e, int head, int qt) {
  const Entry E = get_entry(e);
  const int tid = ltid(), w = tid >> 6, lane = tid & 63, n = lane & 31, h = lane >> 5;
  const int wq0 = qt * 256 + w * 32, tq = wq0 + n; const bool qvalid = tq < E.Tq; const int tqc = qvalid ? tq : E.Tq - 1;
  const int qpos = E.qpos0 + tqc;
  const int nkt = (vis_end(E.samp, min(qt * 256 + 255, E.Tq - 1)) + 63) >> 6;
  const int wvmax = wq0 < E.Tq ? vis_end(E.samp, min(wq0 + 31, E.Tq - 1)) : 0;
  const bf16_t* QB = (const bf16_t*)(P.ws + R_QB); const bf16_t* KB = (const bf16_t*)(P.ws + R_KB);
  const bf16_t* VTb = (const bf16_t*)(P.ws + (E.samp ? R_VTS : R_VT)) + E.vt_off + (size_t)head * HDIM * E.pitch;
  const unsigned short* MASK = (const unsigned short*)(P.ws + R_MASK) + E.mask_off + (size_t)tqc * 2 + h;
  bf16_t* OB = (bf16_t*)(P.ws + R_OB);
  float* biasl = (float*)(lds + 2 * KT_STAGE);
  if (tid < 257) biasl[tid] = P.in[I_RELB][rel_bucket(tid - 128) * NH + head] * LOG2E;
  const float bias_far = P.in[I_RELB][15 * NH + head] * LOG2E;
  bf16x8 qf[8];
  { const bf16_t* qp = QB + (size_t)(E.qrow0 + tqc) * D + head * HDIM + 8 * h;
#pragma unroll
    for (int s = 0; s < 8; ++s) qf[s] = *(const bf16x8*)(qp + 16 * s); }
  f32x16 o[4];
#pragma unroll
  for (int db = 0; db < 4; ++db)
#pragma unroll
    for (int r = 0; r < 16; ++r) o[db][r] = 0.f;
  float m = -1e30f, lsum = 0.f;
  const bf16_t* gK[2]; const bf16_t* gV[2]; int lK[2], lV[2];
#pragma unroll
  for (int i = 0; i < 2; ++i) { const int c = tid + 512 * i;
    gK[i] = KB + (size_t)(E.krow0 + (c >> 4)) * D + head * HDIM + (c & 15) * 8; lK[i] = (c >> 4) * 272 + (c >> 8) * 128 + (c & 15) * 16;
    gV[i] = VTb + (size_t)(c >> 3) * E.pitch + (c & 7) * 8; lV[i] = KT_K + (c >> 3) * 144 + (c & 7) * 16; }
  bf16x8 rk[2], rv[2];
#pragma unroll
  for (int i = 0; i < 2; ++i) { rk[i] = *(const bf16x8*)gK[i]; rv[i] = *(const bf16x8*)gV[i]; }
#pragma unroll
  for (int i = 0; i < 2; ++i) { *(bf16x8*)(lds + lK[i]) = rk[i]; *(bf16x8*)(lds + lV[i]) = rv[i]; }
  __syncthreads();
  unsigned pb0 = 0u, pb1 = 0u;
  if (qvalid && 0 < wvmax) { pb0 = MASK[0]; if (32 < wvmax) pb1 = MASK[(size_t)E.Tq * 2]; }
  const int arow = pi_row(n) * 272 + (pi_row(n) >> 4) * 128 + 16 * h;
  const int vrow = n * 144 + 32 * h;
  for (int kt = 0; kt < nkt; ++kt) {
    const int buf = kt & 1; const bool more = kt + 1 < nkt;
    const unsigned nbits0 = pb0, nbits1 = pb1;
    if (more) {
#pragma unroll
      for (int i = 0; i < 2; ++i) { rk[i] = *(const bf16x8*)(gK[i] + (size_t)(kt + 1) * 64 * D); rv[i] = *(const bf16x8*)(gV[i] + (kt + 1) * 64); }
      pb0 = 0u; pb1 = 0u;
      if (qvalid && 64 * (kt + 1) < wvmax) { pb0 = MASK[(size_t)(2 * kt + 2) * E.Tq * 2]; if (64 * (kt + 1) + 32 < wvmax) pb1 = MASK[(size_t)(2 * kt + 3) * E.Tq * 2]; }
    }
    if (64 * kt < wvmax) {
      const unsigned char* sK = lds + buf * KT_STAGE; const unsigned char* sV = sK + KT_K;
      const bool far_t = 64 * kt + 63 - (E.qpos0 + wq0) <= -91;
      const float binit = far_t ? bias_far : 0.f;
      f32x16 s0, s1;
#pragma unroll
      for (int r = 0; r < 16; ++r) { s0[r] = binit; s1[r] = binit; }
#pragma unroll
      for (int s = 0; s < 8; ++s) {
        const bf16x8 k0 = *(const bf16x8*)(sK + arow + 32 * s), k1 = *(const bf16x8*)(sK + 32 * 272 + 256 + arow + 32 * s);
        s0 = MFMA32(k0, qf[s], s0); s1 = MFMA32(k1, qf[s], s1);
      }
      const unsigned bits0 = nbits0, bits1 = nbits1;
      if (!far_t) {
        const int rel0 = 64 * kt + 16 * h - qpos;
#pragma unroll
        for (int r = 0; r < 16; ++r) {
          const int i0 = min(max(rel0 + r, -128), 128) + 128, i1 = min(max(rel0 + r + 32, -128), 128) + 128;
          s0[r] += biasl[i0]; s1[r] += biasl[i1];
        }
      }
      float mx = -1e30f;
#pragma unroll
      for (int r = 0; r < 16; ++r) {
        const unsigned t0 = (unsigned)__builtin_amdgcn_sbfe((int)bits0, r, 1), t1 = (unsigned)__builtin_amdgcn_sbfe((int)bits1, r, 1);
        s0[r] = __uint_as_float((__float_as_uint(s0[r]) & t0) | (~t0 & 0xff800000u)); s1[r] = __uint_as_float((__float_as_uint(s1[r]) & t1) | (~t1 & 0xff800000u));
        mx = fmaxf(mx, fmaxf(s0[r], s1[r]));
      }
      mx = fmaxf(mx, __shfl_xor(mx, 32));
      const float mn = fmaxf(m, mx);
      if (__any(mn > m)) {
        const float scale = __builtin_amdgcn_exp2f(m - mn); lsum *= scale;
#pragma unroll
        for (int db = 0; db < 4; ++db)
#pragma unroll
          for (int r = 0; r < 16; ++r) o[db][r] *= scale;
      }
      m = mn;
      float ps = 0.f;
#pragma unroll
      for (int r = 0; r < 16; ++r) { s0[r] = __builtin_amdgcn_exp2f(s0[r] - mn); s1[r] = __builtin_amdgcn_exp2f(s1[r] - mn); ps += s0[r] + s1[r]; }
      lsum += ps;
#pragma unroll
      for (int s2 = 0; s2 < 2; ++s2) {
        const bf16x8 p0 = pk8(s0[8 * s2], s0[8 * s2 + 1], s0[8 * s2 + 2], s0[8 * s2 + 3], s0[8 * s2 + 4], s0[8 * s2 + 5], s0[8 * s2 + 6], s0[8 * s2 + 7]);
        const bf16x8 p1 = pk8(s1[8 * s2], s1[8 * s2 + 1], s1[8 * s2 + 2], s1[8 * s2 + 3], s1[8 * s2 + 4], s1[8 * s2 + 5], s1[8 * s2 + 6], s1[8 * s2 + 7]);
#pragma unroll
        for (int db = 0; db < 4; ++db) {
          const bf16x8 v0 = *(const bf16x8*)(sV + db * 32 * 144 + vrow + 16 * s2), v1 = *(const bf16x8*)(sV + db * 32 * 144 + vrow + 64 + 16 * s2);
          o[db] = MFMA32(v0, p0, o[db]); o[db] = MFMA32(v1, p1, o[db]);
        }
      }
    }
    if (more) {
      unsigned char* nb = lds + (buf ^ 1) * KT_STAGE;
#pragma unroll
      for (int i = 0; i < 2; ++i) { *(bf16x8*)(nb + lK[i]) = rk[i]; *(bf16x8*)(nb + lV[i]) = rv[i]; }
    }
    __syncthreads();
  }
  lsum += __shfl_xor(lsum, 32);
  if (qvalid) {
    const float inv = 1.f / lsum; bf16_t* op = OB + (size_t)(E.qrow0 + tq) * D + head * HDIM + 4 * h;
#pragma unroll
    for (int db = 0; db < 4; ++db)
#pragma unroll
      for (int g4 = 0; g4 < 4; ++g4) { u32x2 pk = {pk2(o[db][4 * g4] * inv, o[db][4 * g4 + 1] * inv), pk2(o[db][4 * g4 + 2] * inv, o[db][4 * g4 + 3] * inv)};
        *(u32x2*)(op + 32 * db + 8 * g4) = pk; }
  }
}
DI int next_item_xcd(unsigned* ctrs, unsigned char* lds, int myx, int nper) {
  volatile int* slot = (volatile int*)(lds + LDS_PARAMS + 216);
  __syncthreads();
  if (threadIdx.x == 0) {
    int res = -1;
    for (int k = 0; k < 8 && res < 0; ++k) { const int x = (myx + k) & 7;
      if (__hip_atomic_load(ctrs + x, __ATOMIC_RELAXED, __HIP_MEMORY_SCOPE_AGENT) >= (unsigned)nper) continue;
      const unsigned i = __hip_atomic_fetch_add(ctrs + x, 1u, __ATOMIC_RELAXED, __HIP_MEMORY_SCOPE_AGENT);
      if (i < (unsigned)nper) res = x * nper + (int)i; }
    *slot = res;
  }
  __syncthreads();
  return *slot;
}
DI void dsa_attn_phase(const Params& P, unsigned char* lds, int cidx) {
  constexpr int NPR = NB * 33, NPER = NPR + DB;
  unsigned* ctrs = (unsigned*)(P.ws + WS_BAR + 14336) + 64 + 8 * (cidx >> 3);
  const int myx = (int)(xb_xcc_id() & 7u);
  for (;;) {
    const int it = next_item_xcd(ctrs, lds, myx, NPER); if (it < 0) break;
    const int head = it / NPER, i = it - head * NPER; const bool pr = i < NPR;
    dsa_attn_item(P, lds, pr ? (i & 3) : NB + (i - NPR), head, pr ? 32 - (i >> 2) : 0);
  }
}
DI void sb_item(const Params& P, int e, int head, int g, int lane) {
  const Entry E = get_entry(e);
  const int n = lane & 31, h = lane >> 5;
  const int tq = 32 * g + n; const bool qvalid = tq < E.Tq; const int tqc = qvalid ? tq : E.Tq - 1; const int qpos = E.qpos0 + tqc;
  const bf16_t* QB = (const bf16_t*)(P.ws + R_QB); const bf16_t* KB = (const bf16_t*)(P.ws + R_KB);
  const bf16_t* VTb = (const bf16_t*)(P.ws + (E.samp ? R_VTS : R_VT)) + E.vt_off + (size_t)head * HDIM * E.pitch;
  bf16_t* OB = (bf16_t*)(P.ws + R_OB);
  bf16x8 qf[8];
  { const bf16_t* qp = QB + (size_t)(E.qrow0 + tqc) * D + head * HDIM + 8 * h;
#pragma unroll
    for (int s = 0; s < 8; ++s) qf[s] = *(const bf16x8*)(qp + 16 * s); }
  f32x16 o[4];
#pragma unroll
  for (int db = 0; db < 4; ++db)
#pragma unroll
    for (int r = 0; r < 16; ++r) o[db][r] = 0.f;
  float carry = 0.f;
  const bf16_t* kp0 = KB + (size_t)(E.krow0 + pi_row(n)) * D + head * HDIM + 8 * h;
  const bf16_t* vp0 = VTb + (size_t)n * E.pitch + 16 * h;
  const int kb0 = (E.qpos0 + 32 * g) >> 5;
  bf16x8 kfn[8], vfn[4][2];
#pragma unroll
  for (int s = 0; s < 8; ++s) kfn[s] = *(const bf16x8*)(kp0 + (size_t)kb0 * 32 * D + 16 * s);
#pragma unroll
  for (int db = 0; db < 4; ++db)
#pragma unroll
    for (int s2 = 0; s2 < 2; ++s2) vfn[db][s2] = *(const bf16x8*)(vp0 + (size_t)db * 32 * E.pitch + kb0 * 32 + 8 * s2);
  for (int kb = kb0; kb >= 0; --kb) {
    bf16x8 kf[8], vf[4][2];
#pragma unroll
    for (int s = 0; s < 8; ++s) kf[s] = kfn[s];
#pragma unroll
    for (int db = 0; db < 4; ++db)
#pragma unroll
      for (int s2 = 0; s2 < 2; ++s2) vf[db][s2] = vfn[db][s2];
    { const int kn = kb > 0 ? kb - 1 : 0;
#pragma unroll
      for (int s = 0; s < 8; ++s) kfn[s] = *(const bf16x8*)(kp0 + (size_t)kn * 32 * D + 16 * s);
#pragma unroll
      for (int db = 0; db < 4; ++db)
#pragma unroll
        for (int s2 = 0; s2 < 2; ++s2) vfn[db][s2] = *(const bf16x8*)(vp0 + (size_t)db * 32 * E.pitch + kn * 32 + 8 * s2); }
    f32x16 z;
#pragma unroll
    for (int r = 0; r < 16; ++r) z[r] = 0.f;
#pragma unroll
    for (int s = 0; s < 8; ++s) z = MFMA32(kf[s], qf[s], z);
    float ls[16], bt[16]; float run = 0.f;
#pragma unroll
    for (int r = 15; r >= 0; --r) {
      const int kpos = 32 * kb + 16 * h + r; const bool causal = qvalid && kpos < qpos;
      const float zz = z[r], sp = fmaxf(zz, 0.f) + __logf(1.f + __expf(-fabsf(zz)));
      ls[r] = causal ? zz - sp : -1e30f;
      bt[r] = run; run += causal ? -sp : 0.f;
    }
    const float other = __shfl_xor(run, 32);
    const float base = carry + (h == 0 ? other : 0.f);
    float a[16];
#pragma unroll
    for (int r = 0; r < 16; ++r) a[r] = ls[r] > -1e29f ? __expf(ls[r] + base + bt[r]) : 0.f;
    carry += run + other;
#pragma unroll
    for (int s2 = 0; s2 < 2; ++s2) {
      const bf16x8 pf = pk8(a[8 * s2], a[8 * s2 + 1], a[8 * s2 + 2], a[8 * s2 + 3], a[8 * s2 + 4], a[8 * s2 + 5], a[8 * s2 + 6], a[8 * s2 + 7]);
#pragma unroll
      for (int db = 0; db < 4; ++db) o[db] = MFMA32(vf[db][s2], pf, o[db]);
    }
    const bool done = !qvalid || carry < -30.f;
    if (__all(done)) break;
  }
  if (qvalid) {
    bf16_t* op = OB + (size_t)(E.qrow0 + tq) * D + head * HDIM + 4 * h;
#pragma unroll
    for (int db = 0; db < 4; ++db)
#pragma unroll
      for (int g4 = 0; g4 < 4; ++g4) { u32x2 pk = {pk2(o[db][4 * g4], o[db][4 * g4 + 1]), pk2(o[db][4 * g4 + 2], o[db][4 * g4 + 3])};
        *(u32x2*)(op + 32 * db + 8 * g4) = pk; }
  }
}
DI void sb_phase(const Params& P, int cidx) {
  constexpr int NPI = NB * NH * 257, NIT = NPI + DB * NH;
  const int lane = ltid() & 63;
  unsigned* ctr = (unsigned*)(P.ws + WS_BAR + 14336) + cidx;
  for (;;) {
    int it = 0; if (lane == 0) it = (int)__hip_atomic_fetch_add(ctr, 1u, __ATOMIC_RELAXED, __HIP_MEMORY_SCOPE_AGENT);
    it = __builtin_amdgcn_readfirstlane(it); if (it >= NIT) break;
    const bool pr = it < NPI; const int s = it - NPI; sb_item(P, pr ? (it & 3) : NB + (s >> 3), pr ? ((it >> 2) & 7) : (s & 7), pr ? 256 - (it >> 5) : 0, lane);
  }
}
__global__ void __launch_bounds__(512, 2) fwd_megakernel(Params P0) {
  extern __shared__ __attribute__((aligned(16))) unsigned char shm[];
  cg::grid_group grid = cg::this_grid();
  unsigned char* lds = shm;
  if (threadIdx.x < 2) ((unsigned*)(lds + LDS_PARAMS + 208))[threadIdx.x] = 0u;
  store_params(P0, lds);
  const XcdBarrier xb = xcd_barrier_post((unsigned*)(P0.ws + WS_BAR), (volatile LAS unsigned*)(lds + LDS_PARAMS + 208));
  { const Params P = load_params(lds); phase0(P, lds); }
  grid.sync();
#pragma unroll 1
  for (int l = 0; l < 4; ++l) {
    const bool isA = !(l & 1); const int j = l >> 1;
    { const Params P = load_params(lds); cache_phase(P, lds, isA, j); }
    __syncthreads();
    { const Params P = load_params(lds); EpiInProj E{isA ? 1 : 0, j, P.out, P.ws}; const bf16_t* XB = (const bf16_t*)(P.ws + WS_XB);
      if (isA) { const bf16_t* W = (const bf16_t*)(P.ws + W_AIN) + (size_t)j * A_IN_PAD * D; run_gemm(lds, XB, W, M_MAIN, A_IN_PAD, D, E); tail_gemm(lds, XB, W, A_IN, D, E, (unsigned*)(P.ws + WS_BAR + 14336) + 16 + 5 * l); }
      else { const bf16_t* W = (const bf16_t*)(P.ws + W_BIN) + (size_t)j * B_IN * D; run_gemm(lds, XB, W, M_MAIN, B_IN, D, E); tail_gemm(lds, XB, W, B_IN, D, E, (unsigned*)(P.ws + WS_BAR + 14336) + 16 + 5 * l); } }
    xcd_barrier(xb);
    if (isA) { { const Params P = load_params(lds); indexer_phase(P, lds, 4 * l); } xcd_barrier(xb); { const Params P = load_params(lds); dsa_attn_phase(P, lds, 4 * l + 1); } }
    else { const Params P = load_params(lds); sb_phase(P, 4 * l + 2); }
    xcd_barrier(xb);
    { const Params P = load_params(lds); EpiResid E{(float*)(P.ws + WS_X), (const float*)(P.ws + WS_STATS), P.in[I_LN2G] + (l > 0 ? l - 1 : 0) * D, P.in[I_LN2B] + (l > 0 ? l - 1 : 0) * D, l == 0 ? 1 : 0}; const bf16_t* W = (const bf16_t*)(P.ws + (isA ? W_AOUT : W_BOUT)) + (size_t)j * D * D; run_gemm(lds, (const bf16_t*)(P.ws + R_OB), W, M_MAIN, D, D, E); tail_gemm(lds, (const bf16_t*)(P.ws + R_OB), W, D, D, E, (unsigned*)(P.ws + WS_BAR + 14336) + 16 + 5 * l + 1); }
    xcd_barrier(xb);
    { const Params P = load_params(lds); ln_phase(P, P.in[I_LN1G] + l * D, P.in[I_LN1B] + l * D, false); }
    xcd_barrier(xb);
    { const Params P = load_params(lds); EpiFFN1 E{l, P.out, P.ws}; const bf16_t* W = (const bf16_t*)(P.ws + W_FFN1) + (size_t)l * 2 * DFF * D; run_gemm(lds, (const bf16_t*)(P.ws + WS_XB), W, M_MAIN, 2 * DFF, D, E); tail_gemm(lds, (const bf16_t*)(P.ws + WS_XB), W, 2 * DFF, D, E, (unsigned*)(P.ws + WS_BAR + 14336) + 16 + 5 * l + 2); }
    xcd_barrier(xb);
    { const Params P = load_params(lds); conv_phase(P, l); }
    xcd_barrier(xb);
    { const Params P = load_params(lds); EpiResid E{(float*)(P.ws + WS_X), (const float*)(P.ws + WS_STATS), P.in[I_LN1G] + l * D, P.in[I_LN1B] + l * D, 0}; const bf16_t* W = (const bf16_t*)(P.ws + W_FFN2) + (size_t)l * D * DFF; run_gemm(lds, (const bf16_t*)(P.ws + R_H), W, M_MAIN, D, DFF, E); tail_gemm(lds, (const bf16_t*)(P.ws + R_H), W, D, DFF, E, (unsigned*)(P.ws + WS_BAR + 14336) + 16 + 5 * l + 3); }
    xcd_barrier(xb);
    { const Params P = load_params(lds); ln_phase(P, P.in[I_LN2G] + l * D, P.in[I_LN2B] + l * D, l == 3); }
    if (l < 3) xcd_barrier(xb);
  }
}

extern "C" void kernel_launch(void* const* d_in, const int* in_sizes, int n_in, void* d_out, int out_size, void* d_ws, size_t ws_size, hipStream_t stream) {
  static int grid_blocks = 0;
  if (!grid_blocks) {
    int dev = 0, cus = 0, per_cu = 0;
    hipGetDevice(&dev);
    hipDeviceGetAttribute(&cus, hipDeviceAttributeMultiprocessorCount, dev);
    hipFuncSetAttribute((const void*)fwd_megakernel, hipFuncAttributeMaxDynamicSharedMemorySize, LDS_BYTES);
    hipOccupancyMaxActiveBlocksPerMultiprocessor(&per_cu, fwd_megakernel, 512, LDS_BYTES);
    if (per_cu < 1) per_cu = 1;
    if (per_cu > 1) per_cu = 1;
    grid_blocks = cus * per_cu;
  }
  Params p{};
  for (int i = 0; i < 23; ++i) p.in[i] = (const float*)d_in[i];
  p.out = (float*)d_out; p.ws = (unsigned char*)d_ws;
  if (ws_size < WS_NEED) { fprintf(stderr, "workspace too small: %zu < %zu\n", ws_size, (size_t)WS_NEED); }
  (void)hipMemsetAsync((unsigned char*)d_ws + WS_BAR, 0, 16384, stream);
  void* args[] = {&p};
  hipError_t err = hipLaunchCooperativeKernel((void*)fwd_megakernel, dim3(grid_blocks), dim3(512), args, LDS_BYTES, stream);
  if (err != hipSuccess) fprintf(stderr, "cooperative launch failed: %s (grid %d)\n", hipGetErrorString(err), grid_blocks);
}
```

```cpp
#include <hip/hip_runtime.h>
#include <hip/hip_cooperative_groups.h>
#include <cstdio>
namespace cg = cooperative_groups;
namespace pg8 {
#define PG8_LAS __attribute__((address_space(3)))
typedef unsigned short bf16_t;
typedef short bf16x8 __attribute__((ext_vector_type(8)));
typedef float f32x4 __attribute__((ext_vector_type(4)));
typedef unsigned u32x4 __attribute__((ext_vector_type(4)));
constexpr int BM = 256, BK = 64, HALF = 128, HTB = HALF * BK * 2  , STAGE_BYTES = 8 * HTB, NXCD = 8, WGM = 8;

__host__ __device__ __forceinline__ int lds_byte(int r, int c) { const int st = (r >> 4) * 2 + (c >> 5), rr = r & 15, cc = c & 31, ob = rr * 64 + cc * 2; return st * 1024 + (ob ^ (((ob >> 9) & 1) << 5)); }
__host__ __device__ __forceinline__ void stage_rc(int b, int& R, int& C) { const int st = b / 1024, sb = b % 1024, swz = sb ^ (((sb >> 9) & 1) << 5); R = (st >> 1) * 16 + swz / 64; C = (st & 1) * 32 + (swz % 64) / 2; }
__host__ __device__ __forceinline__ int perm32(int rho) { const int n = rho >> 4, i = rho & 15; return 8 * (i >> 2) + 4 * n + (i & 3); }

struct Unit { int pm, pn; };
struct Gemm { const bf16_t* A; const bf16_t* Bt; int M, N, K; };

struct StaticOrder {
    int nM, nN, nwg, G, c;
    __host__ __device__ void init(int M, int N, int G_, int c_) { nM = M / BM; nN = N / BM; nwg = nM * nN; G = G_; c = c_; }
    __host__ __device__ bool next(int i, Unit& u) const {
        const long L = (long)i * G + c; if (L >= nwg) return false;
        int wgid = (int)L; { const int q = nwg / NXCD, r = nwg % NXCD, xcd = wgid % NXCD, off = wgid / NXCD; wgid = (xcd < r ? xcd * (q + 1) : r * (q + 1) + (xcd - r) * q) + off; }
        const int nig = WGM * nN, gid = wgid / nig, fm = gid * WGM, gsz = (nM - fm) < WGM ? (nM - fm) : WGM;
        u.pm = fm + ((wgid % nig) % gsz); u.pn = (wgid % nig) / gsz; return true;
    }
    __device__ __forceinline__ void a_ready(const Unit&) const {}
    __device__ __forceinline__ void done(const Unit&) const {}
};
template <class Epi, class Sched, bool STAMP = false>
__device__ __forceinline__ void gemm_phase(PG8_LAS unsigned char* lds, const Gemm g, const Sched& S, const Epi& E, unsigned long long* stamps) {
    int tid_l = threadIdx.x; asm volatile("" : "+v"(tid_l)); const int tid = tid_l, wid = __builtin_amdgcn_readfirstlane(tid >> 6), lane = tid & 63, wr = wid >> 2, wc = wid & 3, fr = lane & 15, fq = lane >> 4;
    const int K = g.K, nt = K / BK;
    int ts_lo = 0, ts_hi = 0, nts = 0; const unsigned long long rt_entry = STAMP ? (unsigned long long)wall_clock64() : 0ull;
#define PG8_STAMP() do { if (STAMP && wid == 0 && nts < 64) { const unsigned long long _c = (unsigned long long)clock64(); \
        ts_lo = (lane == nts) ? (int)(unsigned)_c : ts_lo; ts_hi = (lane == nts) ? (int)(unsigned)(_c >> 32) : ts_hi; ++nts; } } while (0)
    PG8_STAMP();
    unsigned voffA[2], voffB[2];
#pragma unroll
    for (int i = 0; i < 2; ++i) { int R, C; stage_rc(tid * 16 + i * 8192, R, C); const int Rb = Epi::PERM ? ((R & ~31) + perm32(R & 31)) : R;
        voffA[i] = (unsigned)(R * K + C) * 2u; voffB[i] = (unsigned)(Rb * K + C) * 2u; }
    const size_t kstep = (size_t)(BK * 2);
    const size_t hstep = (size_t)HALF * K * 2;
    const size_t tstep = 2 * hstep;
    const unsigned ldsw = (unsigned)wid * 1024u;
    const int aoff = lds_byte(wr * 64 + fr, fq * 8), boff = lds_byte(wc * 32 + fr, fq * 8);
#define PG8_SA(b, h) (((b) * 2 + (h)) * HTB)
#define PG8_SB(b, h) ((4 + (b) * 2 + (h)) * HTB)
#define PG8_STAGE(bufoff, gbase, voff) do { _Pragma("unroll") for (int _i = 0; _i < 2; ++_i) \
        __builtin_amdgcn_global_load_lds((const unsigned*)((const char*)(gbase) + (voff)[_i]), (PG8_LAS unsigned*)(lds + (bufoff) + ldsw + _i * 8192), 16, 0, 0); } while (0)
#define PG8_LDA(dst, b, h) do { _Pragma("unroll") for (int m = 0; m < 4; ++m) _Pragma("unroll") for (int k = 0; k < 2; ++k) dst[m][k] = *(const PG8_LAS bf16x8*)(lds + PG8_SA(b, h) + aoff + m * 2048 + k * 1024); } while (0)
#define PG8_LDB(dst, b, h) do { _Pragma("unroll") for (int n = 0; n < 2; ++n) _Pragma("unroll") for (int k = 0; k < 2; ++k) dst[n][k] = *(const PG8_LAS bf16x8*)(lds + PG8_SB(b, h) + boff + n * 2048 + k * 1024); } while (0)
#define PG8_MMA(ai, bj, At, Bt) do { __builtin_amdgcn_s_setprio(1); _Pragma("unroll") for (int m = 0; m < 4; ++m) _Pragma("unroll") for (int n = 0; n < 2; ++n) _Pragma("unroll") for (int k = 0; k < 2; ++k) \
        acc[ai][bj][m][n] = __builtin_amdgcn_mfma_f32_16x16x32_bf16(Bt[n][k], At[m][k], acc[ai][bj][m][n], 0, 0, 0); __builtin_amdgcn_s_setprio(0); } while (0)
#define PG8_WAIT_V(n) asm volatile("s_waitcnt vmcnt(" #n ")" ::: "memory")
#define PG8_WAIT_L(n) asm volatile("s_waitcnt lgkmcnt(" #n ")" ::: "memory")
#define PG8_BAR __builtin_amdgcn_s_barrier()
#define PG8_SCHED __builtin_amdgcn_sched_barrier(0)
    Unit cur, nxt; int ui = 0;
    if (!S.next(0, cur)) return;
    f32x4 acc[2][2][4][2];
#pragma unroll
    for (int a = 0; a < 2; ++a)
#pragma unroll
        for (int b = 0; b < 2; ++b)
#pragma unroll
            for (int m = 0; m < 4; ++m)
#pragma unroll
                for (int n = 0; n < 2; ++n) acc[a][b][m][n] = (f32x4){0.f, 0.f, 0.f, 0.f};
    bf16x8 At[4][2], B0[2][2], B1[2][2];
    const char* cA = (const char*)g.A + (size_t)cur.pm * tstep; const char* cB = (const char*)g.Bt + (size_t)cur.pn * tstep;
    S.a_ready(cur);
    PG8_STAGE(PG8_SB(0, 0), cB, voffB); PG8_STAGE(PG8_SA(0, 0), cA, voffA); PG8_STAGE(PG8_SB(0, 1), cB + hstep, voffB); PG8_STAGE(PG8_SA(0, 1), cA + hstep, voffA);
    if (wr == 1) PG8_BAR;
    PG8_WAIT_V(4); PG8_BAR;
    PG8_STAGE(PG8_SB(1, 0), cB + kstep, voffB); PG8_STAGE(PG8_SA(1, 0), cA + kstep, voffA); PG8_STAGE(PG8_SB(1, 1), cB + hstep + kstep, voffB);
    PG8_WAIT_V(6); PG8_BAR;
    PG8_STAMP();
    for (;;) {
        const bool has_next = S.next(ui + 1, nxt);
        const char* nA = has_next ? (const char*)g.A + (size_t)nxt.pm * tstep : cA; const char* nB = has_next ? (const char*)g.Bt + (size_t)nxt.pn * tstep : cB;
        for (int t = 0; t < nt; t += 2) {
            const bool last = (t == nt - 2);
            const char* a1 = cA + (size_t)(t + 1) * kstep;
            const char* a2 = last ? nA : cA + (size_t)(t + 2) * kstep; const char* b2 = last ? nB : cB + (size_t)(t + 2) * kstep;
            const char* a3 = a2 + kstep; const char* b3 = b2 + kstep;
            if (last && has_next) S.a_ready(nxt);
            PG8_LDB(B0, 0, 0); PG8_SCHED; PG8_LDA(At, 0, 0); PG8_STAGE(PG8_SA(1, 1), a1 + hstep, voffA);
            PG8_WAIT_L(8); PG8_BAR; PG8_WAIT_L(0); PG8_MMA(0, 0, At, B0); PG8_BAR; PG8_SCHED;
            PG8_LDB(B1, 0, 1); PG8_STAGE(PG8_SB(0, 0), b2, voffB);
            PG8_BAR; PG8_WAIT_L(0); PG8_MMA(0, 1, At, B1); PG8_BAR;
            PG8_LDA(At, 0, 1); PG8_STAGE(PG8_SA(0, 0), a2, voffA);
            PG8_BAR; PG8_WAIT_L(0); PG8_MMA(1, 0, At, B0); PG8_BAR; PG8_SCHED;
            PG8_STAGE(PG8_SB(0, 1), b2 + hstep, voffB);
            PG8_WAIT_V(6); PG8_BAR; PG8_MMA(1, 1, At, B1); PG8_BAR;
            PG8_LDB(B0, 1, 0); PG8_SCHED; PG8_LDA(At, 1, 0); PG8_STAGE(PG8_SA(0, 1), a2 + hstep, voffA);
            PG8_WAIT_L(8); PG8_BAR; PG8_WAIT_L(0); PG8_MMA(0, 0, At, B0); PG8_BAR; PG8_SCHED;
            PG8_LDB(B1, 1, 1); PG8_STAGE(PG8_SB(1, 0), b3, voffB);
            PG8_BAR; PG8_WAIT_L(0); PG8_MMA(0, 1, At, B1); PG8_BAR;
            PG8_LDA(At, 1, 1); PG8_STAGE(PG8_SA(1, 0), a3, voffA);
            PG8_BAR; PG8_WAIT_L(0); PG8_MMA(1, 0, At, B0); PG8_BAR; PG8_SCHED;
            PG8_STAGE(PG8_SB(1, 1), b3 + hstep, voffB);
            PG8_WAIT_V(6); PG8_BAR; PG8_MMA(1, 1, At, B1); PG8_BAR;
        }
        PG8_STAMP();
        if constexpr (!Epi::AFTER_DRAIN) { E(acc, cur, wr, wc, fr, fq); S.done(cur); }
        PG8_STAMP();
        if (!has_next) break;
#pragma unroll
        for (int a = 0; a < 2; ++a)
#pragma unroll
            for (int b = 0; b < 2; ++b)
#pragma unroll
                for (int m = 0; m < 4; ++m)
#pragma unroll
                    for (int n = 0; n < 2; ++n) acc[a][b][m][n] = (f32x4){0.f, 0.f, 0.f, 0.f};
        cur = nxt; cA = nA; cB = nB; ++ui;
    }
    PG8_WAIT_V(0);
    if (wr == 0) PG8_BAR;
    PG8_BAR;
    if constexpr (Epi::AFTER_DRAIN) { E.fused(acc, cur, wr, wc, fr, fq, lds, wid, lane); S.done(cur); }
    PG8_STAMP();
    if (STAMP && wid == 0) { stamps[lane] = lane < nts ? (((unsigned long long)(unsigned)ts_hi << 32) | (unsigned)ts_lo) : 0ull;
        if (lane == 62) stamps[62] = rt_entry; if (lane == 63) stamps[63] = (unsigned long long)wall_clock64(); }
#undef PG8_STAMP
#undef PG8_SA
#undef PG8_SB
#undef PG8_STAGE
#undef PG8_LDA
#undef PG8_LDB
#undef PG8_MMA
#undef PG8_WAIT_V
#undef PG8_WAIT_L
#undef PG8_BAR
#undef PG8_SCHED
}
}
using pg8::bf16_t; using pg8::bf16x8; using pg8::f32x4; using pg8::u32x4;
typedef float f32x16 __attribute__((ext_vector_type(16)));
typedef float f32x2 __attribute__((ext_vector_type(2)));
typedef __bf16 bf2_t __attribute__((ext_vector_type(2)));
typedef unsigned u32x2 __attribute__((ext_vector_type(2)));
#define DI __device__ __forceinline__
#define LAS __attribute__((address_space(3)))
DI int ltid() { int t = threadIdx.x; asm volatile("" : "+v"(t)); return t; }
#define MFMA32(a, b, c) __builtin_amdgcn_mfma_f32_32x32x16_bf16((a), (b), (c), 0, 0, 0)

constexpr int D = 1024, NB = 4, SEQ = 8192, NMETA = 16, LP = NMETA + SEQ  , DB = 8, DSEQ = 16, PAST = 2048, LS = PAST + DSEQ  ;
constexpr int NH = 8, HDIM = 128, IDXD = 64, IH = 8, DFF = 2816, TOPK = 256;
constexpr int M_P = NB * LP  , M_S = DB * DSEQ  , M_ALL = M_P + M_S  , M_PAD = 33024, M_MAIN = 32768  ;
constexpr int A_IN = 3656, A_IN_PAD = 3840, B_IN = 3072;
constexpr int LPP = 8256, LSP = 2112;
constexpr int KR_TOT = M_P + DB * LS  , KR_PAD = 49408;
constexpr int NKB_P = 258, NKB_S = 66;
constexpr float ALPHA = 1.6817928305074290f;
constexpr float QSCALE = 0.08838834764831845f;
constexpr float LOG2E = 1.4426950408889634f;
constexpr float WISCALE = 0.04419417382415922f;
constexpr float LN_EPS = 1e-5f;

constexpr size_t O_YP = 0, O_YS = O_YP + (size_t)NB * SEQ * D, O_AKP = O_YS + (size_t)M_S * D, O_AVP = O_AKP + 2ull * M_P * D, O_AIKP = O_AVP + 2ull * M_P * D,
                 O_BKP = O_AIKP + 2ull * M_P * IDXD, O_BVP = O_BKP + 2ull * M_P * D, O_CONVP = O_BVP + 2ull * M_P * D, O_AKS = O_CONVP + 4ull * NB * 2 * DFF,
                 O_AVS = O_AKS + 2ull * M_S * D, O_AIKS = O_AVS + 2ull * M_S * D, O_BKS = O_AIKS + 2ull * M_S * IDXD, O_BVS = O_BKS + 2ull * M_S * D,
                 O_CONVS = O_BVS + 2ull * M_S * D, O_END = O_CONVS + 4ull * DB * 2 * DFF;

constexpr size_t al256(size_t x) { return (x + 255) & ~(size_t)255; }
constexpr size_t W_AIN = 0, W_AOUT = W_AIN + 2ull * A_IN_PAD * D * 2, W_BIN = W_AOUT + 2ull * D * D * 2, W_BOUT = W_BIN + 2ull * B_IN * D * 2,
                 W_FFN1 = W_BOUT + 2ull * D * D * 2, W_FFN2 = W_FFN1 + 4ull * 2 * DFF * D * 2, W_END = W_FFN2 + 4ull * D * DFF * 2;
constexpr size_t WS_X = al256(W_END), WS_XB = WS_X + (size_t)M_PAD * D * 4, WS_KS = WS_XB + (size_t)M_PAD * D * 2;
constexpr size_t WS_R1 = al256(WS_KS);
constexpr size_t R_QB = WS_R1, R_OB = R_QB + (size_t)M_PAD * D * 2, R_KB = R_OB + (size_t)M_PAD * D * 2, R_VT = R_KB + (size_t)KR_PAD * D * 2,
                 R_VTS = R_VT + (size_t)NB * NH * HDIM * LPP * 2, R_QIB = R_VTS + (size_t)DB * NH * HDIM * LSP * 2, R_KIB = R_QIB + (size_t)M_PAD * 512 * 2,
                 R_WIB = R_KIB + (size_t)KR_PAD * IDXD * 2, R_MASK = R_WIB + (size_t)M_PAD * 8 * 4,
                 MASK_S0 = (size_t)NB * NKB_P * LP * 2  , R_THR = al256(R_MASK + (MASK_S0 + (size_t)DB * NKB_S * DSEQ * 2) * 2 + 4096),
                 R_ATT_END = R_THR + (size_t)M_PAD * 4;
constexpr size_t R_G = WS_R1, R_U = R_G + (size_t)M_PAD * DFF * 2, R_H = R_U + (size_t)M_PAD * DFF * 2, R_FFN_END = R_H + (size_t)M_PAD * DFF * 2;
constexpr size_t WS_BAR = al256(R_ATT_END > R_FFN_END ? R_ATT_END : R_FFN_END);
constexpr size_t WS_STATS = WS_BAR + 16384;
constexpr size_t WS_NEED = WS_STATS + (size_t)M_PAD * 8;

constexpr int LDS_PARAMS = 163840 - 256; constexpr int LDS_BYTES = LDS_PARAMS + 256;

struct Params {
  const float* in[23];
  float* out;
  unsigned char* ws;
};
enum { I_XP = 0, I_XS, I_CAK, I_CAV, I_CAIK, I_CBK, I_CBV, I_CONV, I_META, I_RELB, I_WAIN, I_WAOUT, I_WBIN, I_WBOUT, I_LN1G, I_LN1B, I_LN2G, I_LN2B, I_WG, I_WU, I_CW, I_CB, I_WD };


DI void store_params(const Params& P, unsigned char* lds) {
  if (threadIdx.x < 25) { const unsigned long long v = threadIdx.x < 23 ? (unsigned long long)P.in[threadIdx.x < 23 ? threadIdx.x : 0] : (threadIdx.x == 23 ? (unsigned long long)P.out : (unsigned long long)P.ws);
    ((unsigned long long*)(lds + LDS_PARAMS))[threadIdx.x] = v; }
  __syncthreads();
}
DI unsigned long long lds_u64(const unsigned char* lds, int i) {
  const volatile unsigned* p = (const volatile unsigned*)(lds + LDS_PARAMS) + 2 * i; const unsigned lo = __builtin_amdgcn_readfirstlane(p[0]), hi = __builtin_amdgcn_readfirstlane(p[1]);
  return ((unsigned long long)hi << 32) | lo;
}
DI Params load_params(const unsigned char* lds) {
  Params Q;
#pragma unroll
  for (int i = 0; i < 23; ++i) Q.in[i] = (const float*)lds_u64(lds, i);
  Q.out = (float*)lds_u64(lds, 23); Q.ws = (unsigned char*)lds_u64(lds, 24); return Q;
}
DI unsigned pk2(float lo, float hi) { f32x2 v = {lo, hi}; return __builtin_bit_cast(unsigned, __builtin_convertvector(v, bf2_t)); }
DI bf16x8 pk8(float a0, float a1, float a2, float a3, float a4, float a5, float a6, float a7) {
  u32x4 p = {pk2(a0, a1), pk2(a2, a3), pk2(a4, a5), pk2(a6, a7)}; return __builtin_bit_cast(bf16x8, p); }
DI float bf2f(unsigned short b) { return __uint_as_float(((unsigned)b) << 16); }
DI int pi_row(int i) { return 16 * ((i >> 2) & 1) + 4 * (i >> 3) + (i & 3); }

DI int snake_item(int round, int b, int G) { return round * G + ((round & 1) ? (G - 1 - b) : b); }

struct Entry { int Tq, L, qrow0, krow0, qpos0, pitch; size_t vt_off  , mask_off; bool samp; };
DI Entry get_entry(int e) {
  Entry E;
  if (e < NB) { E.Tq = LP; E.L = LP; E.qrow0 = e * LP; E.krow0 = e * LP; E.qpos0 = 0; E.pitch = LPP; E.vt_off = (size_t)e * NH * HDIM * LPP; E.mask_off = (size_t)e * NKB_P * LP * 2; E.samp = false; }
  else { const int sb = e - NB; E.Tq = DSEQ; E.L = LS; E.qrow0 = M_P + sb * DSEQ; E.krow0 = M_P + sb * LS; E.qpos0 = PAST; E.pitch = LSP; E.vt_off = (size_t)sb * NH * HDIM * LSP; E.mask_off = MASK_S0 + (size_t)sb * NKB_S * DSEQ * 2; E.samp = true; }
  return E;
}
DI int vis_end(bool samp, int tq) { return samp ? LS : (tq < NMETA ? NMETA : NMETA + 64 * (((tq - NMETA) >> 6) + 1)); }
DI int rel_bucket(int rel) {
  const int n = rel < 0 ? -rel : rel; int b;
  if (n < 8) b = n; else if (n < 12) b = 8; else if (n < 16) b = 9; else if (n < 23) b = 10; else if (n < 32) b = 11; else if (n < 46) b = 12; else if (n < 64) b = 13; else if (n < 91) b = 14; else b = 15;
  return b + (rel > 0 ? 16 : 0);
}
#define XB_TMO      128
#define XB_XCNT(j)  (256  + 64 * (j))
#define XB_XSUB(j)  (1280 + 64 * (j))
#define XB_XGEN(j)  (2304 + 64 * (j))
#define XB_TOP      3328
#define XB_TOPGEN   3392
#define XCD_BAR_WORDS 3456
#define XB_SPIN_CAP (1u << 18)

__device__ __forceinline__ unsigned xb_ld(unsigned* p)              { return __hip_atomic_load(p, __ATOMIC_RELAXED, __HIP_MEMORY_SCOPE_AGENT); }
__device__ __forceinline__ unsigned xb_add(unsigned* p, unsigned v) { return __hip_atomic_fetch_add(p, v, __ATOMIC_RELAXED, __HIP_MEMORY_SCOPE_AGENT); }
__device__ __forceinline__ unsigned xb_xcc_id() { return (unsigned)__builtin_amdgcn_s_getreg((3 << 11) | 20) & 0xFu; }
#define XB_SPIN(cond, bar) do { unsigned _sp = 0; while (cond) { __builtin_amdgcn_s_sleep(1); \
    if ((++_sp & 255u) == 0u) { if (xb_ld(&(bar)[XB_TMO])) break; if (_sp > XB_SPIN_CAP) { atomicAdd(&(bar)[XB_TMO], 1u); break; } } } } while (0)

struct XcdBarrier {
    unsigned* bar; unsigned x;
    volatile LAS unsigned* st;
};

__device__ __forceinline__ XcdBarrier xcd_barrier_post(unsigned* bar, volatile LAS unsigned* st) {
    XcdBarrier b; b.bar = bar; b.x = xb_xcc_id(); b.st = st;
    if (threadIdx.x == 0) (void)xb_add(&bar[XB_XCNT(b.x)], 1u);
    return b;
}
__device__ __forceinline__ void xcd_barrier_complete(unsigned* bar, unsigned x, unsigned& nloc, unsigned& nx) {
    const unsigned G = gridDim.x * gridDim.y * gridDim.z;
    unsigned sum, cnt, mine, sp = 0u;
    for (;;) {
        sum = 0u; cnt = 0u; mine = 0u;
#pragma unroll
        for (unsigned j = 0; j < 16; ++j) { const unsigned c = xb_ld(&bar[XB_XCNT(j)]); sum += c; cnt += (c > 0u) ? 1u : 0u; mine = (j == x) ? c : mine; }
        if (sum == G) break;
        __builtin_amdgcn_s_sleep(1);
        if ((++sp & 255u) == 0u) { if (xb_ld(&bar[XB_TMO])) break; if (sp > XB_SPIN_CAP) { atomicAdd(&bar[XB_TMO], 1u); break; } }
    }
    nloc = mine > 0u ? mine : 1u; nx = cnt > 0u ? cnt : 1u;
}

__device__ __forceinline__ void xcd_barrier(const XcdBarrier& b) {
    asm volatile("s_waitcnt vmcnt(0)" ::: "memory");
    __syncthreads();
    if (threadIdx.x == 0) {
        unsigned* bar = b.bar;
        __builtin_amdgcn_s_waitcnt(0);
        unsigned nloc = b.st[0], nx = b.st[1];
        if (nloc == 0u) { xcd_barrier_complete(bar, b.x, nloc, nx); b.st[0] = nloc; b.st[1] = nx; }
        const unsigned old = xb_add(&bar[XB_XSUB(b.x)], 1u);
        const unsigned gen = old / nloc;
        if (old + 1u == (gen + 1u) * nloc) {
            __builtin_amdgcn_fence(__ATOMIC_RELEASE, "agent");
            asm volatile("s_waitcnt vmcnt(0)" ::: "memory");
            const unsigned og = xb_add(&bar[XB_TOP], 1u);
            const unsigned tg = og / nx;
            if (og + 1u == (tg + 1u) * nx) xb_add(&bar[XB_TOPGEN], 1u);
            else XB_SPIN(xb_ld(&bar[XB_TOPGEN]) == tg, bar);
            __builtin_amdgcn_fence(__ATOMIC_ACQUIRE, "agent");
            xb_add(&bar[XB_XGEN(b.x)], 1u);
            asm volatile("s_waitcnt vmcnt(0)" ::: "memory");
        } else {
            XB_SPIN(xb_ld(&bar[XB_XGEN(b.x)]) == gen, bar);
            __builtin_amdgcn_fence(__ATOMIC_ACQUIRE, "agent");
            asm volatile("s_waitcnt vmcnt(0)" ::: "memory");
        }
    }
    __syncthreads();
}


DI void wjob(const Params& P, int job, const float*& src, int& K, int& N, bf16_t*& dst) {
  if (job < 2) { src = P.in[I_WAIN] + (size_t)job * D * A_IN; K = D; N = A_IN; dst = (bf16_t*)(P.ws + W_AIN) + (size_t)job * A_IN_PAD * D; }
  else if (job < 4) { const int j = job - 2; src = P.in[I_WAOUT] + (size_t)j * D * D; K = D; N = D; dst = (bf16_t*)(P.ws + W_AOUT) + (size_t)j * D * D; }
  else if (job < 6) { const int j = job - 4; src = P.in[I_WBIN] + (size_t)j * D * B_IN; K = D; N = B_IN; dst = (bf16_t*)(P.ws + W_BIN) + (size_t)j * B_IN * D; }
  else if (job < 8) { const int j = job - 6; src = P.in[I_WBOUT] + (size_t)j * D * D; K = D; N = D; dst = (bf16_t*)(P.ws + W_BOUT) + (size_t)j * D * D; }
  else if (job < 12) { const int l = job - 8; src = P.in[I_WG] + (size_t)l * D * DFF; K = D; N = DFF; dst = (bf16_t*)(P.ws + W_FFN1) + (size_t)l * 2 * DFF * D; }
  else if (job < 16) { const int l = job - 12; src = P.in[I_WU] + (size_t)l * D * DFF; K = D; N = DFF; dst = (bf16_t*)(P.ws + W_FFN1) + (size_t)l * 2 * DFF * D + (size_t)DFF * D; }
  else { const int l = job - 16; src = P.in[I_WD] + (size_t)l * DFF * D; K = DFF; N = D; dst = (bf16_t*)(P.ws + W_FFN2) + (size_t)l * D * DFF; }
}
struct TrTile { const float* src; size_t spitch; int nlim; bf16_t* dst; size_t dpitch; };
DI void tr_load(float (&v)[8], const TrTile& t, int tid) {
#pragma unroll
  for (int i = 0; i < 8; ++i) { const int kk = (tid >> 6) + 8 * i, nn = tid & 63; v[i] = nn < t.nlim ? t.src[(size_t)kk * t.spitch + nn] : 0.f; }
}
template <class F> DI void tr_loop(int ntiles, F info, float* tl  ) {
  const int tid = ltid(); float v[8]; int T = blockIdx.x; TrTile cur{}, nxt{};
  if (T < ntiles) { cur = info(T); tr_load(v, cur, tid); }
  for (; T < ntiles; T += gridDim.x) {
#pragma unroll
    for (int i = 0; i < 8; ++i) { const int kk = (tid >> 6) + 8 * i, nn = tid & 63; tl[nn * 65 + kk] = v[i]; }
    const int Tn = T + gridDim.x;
    if (Tn < ntiles) { nxt = info(Tn); tr_load(v, nxt, tid); }
    __syncthreads();
#pragma unroll
    for (int i = 0; i < 4; ++i) { const int nn = (tid >> 5) + 16 * i, kk = 2 * (tid & 31); *(unsigned*)(cur.dst + (size_t)nn * cur.dpitch + kk) = pk2(tl[nn * 65 + kk], tl[nn * 65 + kk + 1]); }
    __syncthreads();
    cur = nxt;
  }
}
DI void phase0(const Params& P, unsigned char* lds) {
  float* tl = (float*)lds;
  tr_loop(12864, [&](int T) {
    int job, t;
    if (T < 1856) { job = T / 928; t = T - job * 928; }
    else if (T < 2368) { job = 2 + (T - 1856) / 256; t = (T - 1856) & 255; }
    else if (T < 3904) { job = 4 + (T - 2368) / 768; t = (T - 2368) % 768; }
    else if (T < 4416) { job = 6 + (T - 3904) / 256; t = (T - 3904) & 255; }
    else { job = 8 + (T - 4416) / 704; t = (T - 4416) % 704; }
    const float* src; int K, N; bf16_t* dst; wjob(P, job, src, K, N, dst);
    const int ntn = (N + 63) >> 6, tk = t / ntn, tn = t - tk * ntn;
    return TrTile{src + (size_t)tk * 64 * N + tn * 64, (size_t)N, N - tn * 64, dst + (size_t)tn * 64 * K + tk * 64, (size_t)K};
  }, tl);
  float* X = (float*)(P.ws + WS_X); bf16_t* XB = (bf16_t*)(P.ws + WS_XB);
  const size_t nth = (size_t)gridDim.x * 512, gt = (size_t)blockIdx.x * 512 + ltid();
  for (size_t i0 = gt; i0 < (size_t)M_ALL * 256; i0 += 4 * nth) {
    f32x4 v[4]; size_t dsti[4]; bool ok[4];
#pragma unroll
    for (int k = 0; k < 4; ++k) { const size_t i = i0 + (size_t)k * nth; ok[k] = i < (size_t)M_ALL * 256; const size_t ic = ok[k] ? i : 0;
      const int row = (int)(ic >> 8), c4 = (int)(ic & 255); const float* sp;
      if (row < M_P) { const int b = row / LP, t = row - b * LP; sp = t < NMETA ? P.in[I_META] + (size_t)t * D : P.in[I_XP] + ((size_t)b * SEQ + (t - NMETA)) * D; }
      else sp = P.in[I_XS] + (size_t)(row - M_P) * D;
      v[k] = *(const f32x4*)(sp + 4 * c4); dsti[k] = (size_t)row * D + 4 * c4; }
#pragma unroll
    for (int k = 0; k < 4; ++k) if (ok[k]) { *(f32x4*)(X + dsti[k]) = v[k]; u32x2 pk = {pk2(v[k][0], v[k][1]), pk2(v[k][2], v[k][3])}; *(u32x2*)(XB + dsti[k]) = pk; }
  }
}
DI void cache_phase(const Params& P, unsigned char* lds, bool isA, int j) {
  const float* ck = (isA ? P.in[I_CAK] : P.in[I_CBK]) + (size_t)j * DB * PAST * D;
  const float* cv = (isA ? P.in[I_CAV] : P.in[I_CBV]) + (size_t)j * DB * PAST * D;
  bf16_t* KB = (bf16_t*)(P.ws + R_KB); bf16_t* VTS = (bf16_t*)(P.ws + R_VTS); bf16_t* KIB = (bf16_t*)(P.ws + R_KIB);
  const size_t nth = (size_t)gridDim.x * 512, gt = (size_t)blockIdx.x * 512 + ltid();
  for (size_t i0 = gt; i0 < (size_t)DB * PAST * 256; i0 += 4 * nth) {
    f32x4 v[4];
#pragma unroll
    for (int k = 0; k < 4; ++k) { const size_t i = i0 + (size_t)k * nth; v[k] = *(const f32x4*)(ck + (i < (size_t)DB * PAST * 256 ? i : 0) * 4); }
#pragma unroll
    for (int k = 0; k < 4; ++k) { const size_t i = i0 + (size_t)k * nth; if (i >= (size_t)DB * PAST * 256) break;
      const int c4 = (int)(i & 255); const int rp = (int)(i >> 8); const int sb = rp >> 11, pos = rp & 2047;
      u32x2 pk = {pk2(v[k][0], v[k][1]), pk2(v[k][2], v[k][3])}; *(u32x2*)(KB + (size_t)(M_P + sb * LS + pos) * D + 4 * c4) = pk; }
  }
  if (isA) {
    const float* cik = P.in[I_CAIK] + (size_t)j * DB * PAST * IDXD;
    for (size_t i = gt; i < (size_t)DB * PAST * 16; i += nth) {
      const int c4 = (int)(i & 15); const int rp = (int)(i >> 4); const int sb = rp >> 11, pos = rp & 2047;
      const f32x4 v = *(const f32x4*)(cik + (size_t)rp * IDXD + 4 * c4);
      u32x2 pk = {pk2(v[0], v[1]), pk2(v[2], v[3])}; *(u32x2*)(KIB + (size_t)(M_P + sb * LS + pos) * IDXD + 4 * c4) = pk;
    }
  }
  float* tl = (float*)lds;
  tr_loop(DB * NH * 32 * 2, [&](int t) {
    const int dt = t & 1, pt = (t >> 1) & 31, head = (t >> 6) & 7, sb = t >> 9;
    return TrTile{cv + ((size_t)sb * PAST + pt * 64) * D + head * HDIM + dt * 64, (size_t)D, 64, VTS + ((size_t)(sb * NH + head) * HDIM + dt * 64) * LSP + pt * 64, (size_t)LSP};
  }, tl);
}
struct EpiInProj {
  static constexpr bool PERM = true, AFTER_DRAIN = false;
  int isA, j; float* out; unsigned char* ws;
  __device__ __forceinline__ void operator()(const f32x4 (&acc)[2][2][4][2], const pg8::Unit& u, int wr, int wc, int fr, int fq) const {
    const int pn = u.pn; const int sec = pn >> 2;
    bf16_t* QB = (bf16_t*)(ws + R_QB); bf16_t* KB = (bf16_t*)(ws + R_KB); bf16_t* VT = (bf16_t*)(ws + R_VT); bf16_t* VTS = (bf16_t*)(ws + R_VTS);
    bf16_t* QIB = (bf16_t*)(ws + R_QIB); bf16_t* KIB = (bf16_t*)(ws + R_KIB); float* WIB = (float*)(ws + R_WIB);
#pragma unroll
    for (int ai = 0; ai < 2; ++ai)
#pragma unroll
      for (int m = 0; m < 4; ++m) {
        const int row = u.pm * 256 + ai * 128 + wr * 64 + m * 16 + fr;
        if (row >= M_ALL) continue;
        const bool samp = row >= M_P; const int srow = row - M_P;
        const int b = samp ? (srow >> 4) : row / LP; const int t = samp ? (srow & 15) : row - b * LP;
        const int krow = samp ? M_P + b * LS + PAST + t : row;
#pragma unroll
        for (int bj = 0; bj < 2; ++bj) {
          const int col = pn * 256 + bj * 128 + wc * 32 + 8 * fq; const f32x4 v0 = acc[ai][bj][m][0], v1 = acc[ai][bj][m][1];
          if (sec == 0) { const float qs = isA ? QSCALE * LOG2E : QSCALE; u32x4 pk = {pk2(v0[0] * qs, v0[1] * qs), pk2(v0[2] * qs, v0[3] * qs), pk2(v1[0] * qs, v1[1] * qs), pk2(v1[2] * qs, v1[3] * qs)}; *(u32x4*)(QB + (size_t)row * D + col) = pk; }
          else if (sec == 1) { const int c = col - D;
            float* o = samp ? out + (isA ? O_AKS : O_BKS) + (size_t)j * M_S * D + (size_t)srow * D + c : out + (isA ? O_AKP : O_BKP) + (size_t)j * M_P * D + (size_t)row * D + c;
            *(f32x4*)o = v0; *(f32x4*)(o + 4) = v1; u32x4 pk = {pk2(v0[0], v0[1]), pk2(v0[2], v0[3]), pk2(v1[0], v1[1]), pk2(v1[2], v1[3])}; *(u32x4*)(KB + (size_t)krow * D + c) = pk; }
          else if (sec == 2) { const int c = col - 2 * D;
            float* o = samp ? out + (isA ? O_AVS : O_BVS) + (size_t)j * M_S * D + (size_t)srow * D + c : out + (isA ? O_AVP : O_BVP) + (size_t)j * M_P * D + (size_t)row * D + c;
            *(f32x4*)o = v0; *(f32x4*)(o + 4) = v1; const int head = c >> 7, d = c & 127;
            bf16_t* vt = samp ? VTS + ((size_t)(b * NH + head) * HDIM + d) * LSP + PAST + t : VT + ((size_t)(b * NH + head) * HDIM + d) * LPP + t;
            const int pitch = samp ? LSP : LPP; const unsigned p01 = pk2(v0[0], v0[1]), p23 = pk2(v0[2], v0[3]), p45 = pk2(v1[0], v1[1]), p67 = pk2(v1[2], v1[3]);
            vt[0] = (bf16_t)(p01 & 0xffff); vt[pitch] = (bf16_t)(p01 >> 16); vt[2 * pitch] = (bf16_t)(p23 & 0xffff); vt[3 * pitch] = (bf16_t)(p23 >> 16);
            vt[4 * pitch] = (bf16_t)(p45 & 0xffff); vt[5 * pitch] = (bf16_t)(p45 >> 16); vt[6 * pitch] = (bf16_t)(p67 & 0xffff); vt[7 * pitch] = (bf16_t)(p67 >> 16); }
          else { const int c = col - 3 * D;
            if (c < 512) { u32x4 pk = {pk2(v0[0], v0[1]), pk2(v0[2], v0[3]), pk2(v1[0], v1[1]), pk2(v1[2], v1[3])}; *(u32x4*)(QIB + (size_t)row * 512 + c) = pk; }
            else if (c < 576) { const int cc = c - 512;
              float* o = samp ? out + O_AIKS + (size_t)j * M_S * IDXD + (size_t)srow * IDXD + cc : out + O_AIKP + (size_t)j * M_P * IDXD + (size_t)row * IDXD + cc;
              *(f32x4*)o = v0; *(f32x4*)(o + 4) = v1; u32x4 pk = {pk2(v0[0], v0[1]), pk2(v0[2], v0[3]), pk2(v1[0], v1[1]), pk2(v1[2], v1[3])}; *(u32x4*)(KIB + (size_t)krow * IDXD + cc) = pk; }
            else if (c < 584) { f32x4 w0 = {v0[0] * WISCALE, v0[1] * WISCALE, v0[2] * WISCALE, v0[3] * WISCALE}, w1 = {v1[0] * WISCALE, v1[1] * WISCALE, v1[2] * WISCALE, v1[3] * WISCALE};
              *(f32x4*)(WIB + (size_t)row * 8) = w0; *(f32x4*)(WIB + (size_t)row * 8 + 4) = w1; }
          }
        }
      }
  }
  __device__ __forceinline__ void st(int row, int col, const f32x4& v) const {
    bf16_t* QB = (bf16_t*)(ws + R_QB); bf16_t* KB = (bf16_t*)(ws + R_KB); bf16_t* VT = (bf16_t*)(ws + R_VT); bf16_t* VTS = (bf16_t*)(ws + R_VTS);
    bf16_t* QIB = (bf16_t*)(ws + R_QIB); bf16_t* KIB = (bf16_t*)(ws + R_KIB); float* WIB = (float*)(ws + R_WIB);
    const int sec = col >> 10;
    const bool samp = row >= M_P; const int srow = row - M_P;
    const int b = samp ? (srow >> 4) : row / LP; const int t = samp ? (srow & 15) : row - b * LP;
    const int krow = samp ? M_P + b * LS + PAST + t : row;
    if (sec == 0) { const float qs = isA ? QSCALE * LOG2E : QSCALE; u32x2 pk = {pk2(v[0] * qs, v[1] * qs), pk2(v[2] * qs, v[3] * qs)}; *(u32x2*)(QB + (size_t)row * D + col) = pk; }
    else if (sec == 1) { const int c = col - D;
      float* o = samp ? out + (isA ? O_AKS : O_BKS) + (size_t)j * M_S * D + (size_t)srow * D + c : out + (isA ? O_AKP : O_BKP) + (size_t)j * M_P * D + (size_t)row * D + c;
      *(f32x4*)o = v; u32x2 pk = {pk2(v[0], v[1]), pk2(v[2], v[3])}; *(u32x2*)(KB + (size_t)krow * D + c) = pk; }
    else if (sec == 2) { const int c = col - 2 * D;
      float* o = samp ? out + (isA ? O_AVS : O_BVS) + (size_t)j * M_S * D + (size_t)srow * D + c : out + (isA ? O_AVP : O_BVP) + (size_t)j * M_P * D + (size_t)row * D + c;
      *(f32x4*)o = v; const int head = c >> 7, d = c & 127;
      bf16_t* vt = samp ? VTS + ((size_t)(b * NH + head) * HDIM + d) * LSP + PAST + t : VT + ((size_t)(b * NH + head) * HDIM + d) * LPP + t;
      const int pitch = samp ? LSP : LPP; const unsigned p01 = pk2(v[0], v[1]), p23 = pk2(v[2], v[3]);
      vt[0] = (bf16_t)(p01 & 0xffff); vt[pitch] = (bf16_t)(p01 >> 16); vt[2 * pitch] = (bf16_t)(p23 & 0xffff); vt[3 * pitch] = (bf16_t)(p23 >> 16); }
    else if (isA) { const int c = col - 3 * D;
      if (c < 512) { u32x2 pk = {pk2(v[0], v[1]), pk2(v[2], v[3])}; *(u32x2*)(QIB + (size_t)row * 512 + c) = pk; }
      else if (c < 576) { const int cc = c - 512;
        float* o = samp ? out + O_AIKS + (size_t)j * M_S * IDXD + (size_t)srow * IDXD + cc : out + O_AIKP + (size_t)j * M_P * IDXD + (size_t)row * IDXD + cc;
        *(f32x4*)o = v; u32x2 pk = {pk2(v[0], v[1]), pk2(v[2], v[3])}; *(u32x2*)(KIB + (size_t)krow * IDXD + cc) = pk; }
      else if (c < 584) { f32x4 wv = {v[0] * WISCALE, v[1] * WISCALE, v[2] * WISCALE, v[3] * WISCALE}; *(f32x4*)(WIB + (size_t)row * 8 + (c - 576)) = wv; }
    }
  }
};
struct EpiResid {
  static constexpr bool PERM = true, AFTER_DRAIN = false;
  float* X; const float* stats; const float* g; const float* b; int noln;
  __device__ __forceinline__ void operator()(const f32x4 (&acc)[2][2][4][2], const pg8::Unit& u, int wr, int wc, int fr, int fq) const {
#pragma unroll
    for (int bj = 0; bj < 2; ++bj) {
      const int col = u.pn * 256 + bj * 128 + wc * 32 + 8 * fq;
      f32x4 gv0 = {1.f, 1.f, 1.f, 1.f}, gv1 = gv0, bv0 = {0.f, 0.f, 0.f, 0.f}, bv1 = bv0;
      if (!noln) { gv0 = *(const f32x4*)(g + col); gv1 = *(const f32x4*)(g + col + 4); bv0 = *(const f32x4*)(b + col); bv1 = *(const f32x4*)(b + col + 4); }
#pragma unroll
      for (int ai = 0; ai < 2; ++ai)
#pragma unroll
        for (int m = 0; m < 4; ++m) {
          const int row = u.pm * 256 + ai * 128 + wr * 64 + m * 16 + fr;
          if (row >= M_ALL) continue;
          float mu = 0.f, rs = 1.f;
          if (!noln) { const f32x2 st2 = *(const f32x2*)(stats + 2 * (size_t)row); mu = st2[0]; rs = st2[1]; }
          float* p = X + (size_t)row * D + col; const f32x4 x0 = *(const f32x4*)p, x1 = *(const f32x4*)(p + 4); const f32x4 v0 = acc[ai][bj][m][0], v1 = acc[ai][bj][m][1];
          const f32x4 n0 = (x0 - mu) * rs * gv0 + bv0, n1 = (x1 - mu) * rs * gv1 + bv1;
          f32x4 r0 = {ALPHA * n0[0] + v0[0], ALPHA * n0[1] + v0[1], ALPHA * n0[2] + v0[2], ALPHA * n0[3] + v0[3]}, r1 = {ALPHA * n1[0] + v1[0], ALPHA * n1[1] + v1[1], ALPHA * n1[2] + v1[2], ALPHA * n1[3] + v1[3]};
          *(f32x4*)p = r0; *(f32x4*)(p + 4) = r1;
        }
      __builtin_amdgcn_sched_barrier(0);
    }
  }
  __device__ __forceinline__ void st(int row, int col, const f32x4& v) const {
    f32x4 gv = {1.f, 1.f, 1.f, 1.f}, bv = {0.f, 0.f, 0.f, 0.f}; float mu = 0.f, rs = 1.f;
    if (!noln) { gv = *(const f32x4*)(g + col); bv = *(const f32x4*)(b + col); const f32x2 st2 = *(const f32x2*)(stats + 2 * (size_t)row); mu = st2[0]; rs = st2[1]; }
    float* p = X + (size_t)row * D + col; const f32x4 x = *(const f32x4*)p; const f32x4 xn = (x - mu) * rs * gv + bv;
    f32x4 r = {ALPHA * xn[0] + v[0], ALPHA * xn[1] + v[1], ALPHA * xn[2] + v[2], ALPHA * xn[3] + v[3]}; *(f32x4*)p = r;
  }
};
struct EpiFFN1 {
  static constexpr bool PERM = true, AFTER_DRAIN = false;
  int l; float* out; unsigned char* ws;
  __device__ __forceinline__ void operator()(const f32x4 (&acc)[2][2][4][2], const pg8::Unit& u, int wr, int wc, int fr, int fq) const {
    const bool gate = u.pn < 11; bf16_t* dst = (bf16_t*)(ws + (gate ? R_G : R_U));
#pragma unroll
    for (int ai = 0; ai < 2; ++ai)
#pragma unroll
      for (int m = 0; m < 4; ++m) {
        const int row = u.pm * 256 + ai * 128 + wr * 64 + m * 16 + fr;
        if (row >= M_ALL) continue;
        float* cst = nullptr;
        if (gate) {
          if (row >= M_P) { const int srow = row - M_P, sb = srow >> 4, t = srow & 15; if (t >= DSEQ - 2) cst = out + O_CONVS + ((size_t)(l * DB + sb) * 2 + (t - (DSEQ - 2))) * DFF; }
          else { const int b = row / LP, t = row - b * LP; if (t >= LP - 2) cst = out + O_CONVP + ((size_t)(l * NB + b) * 2 + (t - (LP - 2))) * DFF; }
        }
#pragma unroll
        for (int bj = 0; bj < 2; ++bj) {
          const int col = (gate ? u.pn : u.pn - 11) * 256 + bj * 128 + wc * 32 + 8 * fq; const f32x4 v0 = acc[ai][bj][m][0], v1 = acc[ai][bj][m][1];
          u32x4 pk = {pk2(v0[0], v0[1]), pk2(v0[2], v0[3]), pk2(v1[0], v1[1]), pk2(v1[2], v1[3])}; *(u32x4*)(dst + (size_t)row * DFF + col) = pk;
          if (cst) { *(f32x4*)(cst + col) = v0; *(f32x4*)(cst + col + 4) = v1; }
        }
      }
  }
  __device__ __forceinline__ void st(int row, int col, const f32x4& v) const {
    const bool gate = col < DFF; bf16_t* dst = (bf16_t*)(ws + (gate ? R_G : R_U)); const int c = gate ? col : col - DFF;
    u32x2 pk = {pk2(v[0], v[1]), pk2(v[2], v[3])}; *(u32x2*)(dst + (size_t)row * DFF + c) = pk;
    if (gate) {
      if (row >= M_P) { const int srow = row - M_P, sb = srow >> 4, t = srow & 15; if (t >= DSEQ - 2) *(f32x4*)(out + O_CONVS + ((size_t)(l * DB + sb) * 2 + (t - (DSEQ - 2))) * DFF + c) = v; }
      else { const int b = row / LP, t = row - b * LP; if (t >= LP - 2) *(f32x4*)(out + O_CONVP + ((size_t)(l * NB + b) * 2 + (t - (LP - 2))) * DFF + c) = v; }
    }
  }
};
template <class Epi> DI void run_gemm(unsigned char* lds, const bf16_t* A, const bf16_t* Bt, int M, int N, int K, const Epi& E) {
  pg8::Gemm g{A, Bt, M, N, K}; pg8::StaticOrder S; S.init(M, N, (int)gridDim.x, (int)blockIdx.x);
  pg8::gemm_phase<Epi, pg8::StaticOrder, false>((LAS unsigned char*)lds, g, S, E, nullptr);
}
DI int next_item(unsigned* ctr, unsigned char* lds) {
  volatile unsigned* slot = (volatile unsigned*)(lds + LDS_PARAMS + 216);
  __syncthreads();
  if (threadIdx.x == 0) *slot = __hip_atomic_fetch_add(ctr, 1u, __ATOMIC_RELAXED, __HIP_MEMORY_SCOPE_AGENT);
  __syncthreads();
  return (int)*slot;
}
template <class Epi> DI void tail_gemm(unsigned char* lds, const bf16_t* A, const bf16_t* Bt, int N, int K, const Epi& E, unsigned* ctr) {
  const int tid = ltid(), w = tid >> 6, lane = tid & 63, n = lane & 31, h = lane >> 5;
  const int ntn = (N + 31) >> 5, ntiles = 6 * ntn, kw = K >> 3;
  float* red = (float*)lds;
  for (;;) {
    const int t = next_item(ctr, lds); if (t >= ntiles) break;
    const int nt = t / 6, mt = t - nt * 6;
    const bf16_t* ap = A + (size_t)(M_MAIN + 32 * mt + n) * K + w * kw + 8 * h;
    const bf16_t* bp = Bt + (size_t)(32 * nt + n) * K + w * kw + 8 * h;
    f32x16 acc;
#pragma unroll
    for (int r = 0; r < 16; ++r) acc[r] = 0.f;
#pragma unroll 2
    for (int k0 = 0; k0 < kw; k0 += 32) {
      const bf16x8 a0 = *(const bf16x8*)(bp + k0), a1 = *(const bf16x8*)(bp + k0 + 16), b0 = *(const bf16x8*)(ap + k0), b1 = *(const bf16x8*)(ap + k0 + 16);
      acc = MFMA32(a0, b0, acc); acc = MFMA32(a1, b1, acc);
    }
#pragma unroll
    for (int r = 0; r < 16; ++r) red[(w * 16 + r) * 64 + lane] = acc[r];
    __syncthreads();
    if (w < 4) {
      f32x4 v = {0.f, 0.f, 0.f, 0.f};
#pragma unroll
      for (int ww = 0; ww < 8; ++ww)
#pragma unroll
        for (int i = 0; i < 4; ++i) v[i] += red[(ww * 16 + 4 * w + i) * 64 + lane];
      E.st(M_MAIN + 32 * mt + n, 32 * nt + 8 * w + 4 * h, v);
    }
    __syncthreads();
  }
}
DI float wave_sum(float v) {
#pragma unroll
  for (int o = 32; o >= 1; o >>= 1) v += __shfl_xor(v, o);
  return v;
}
DI void ln_phase(const Params& P, const float* __restrict__ g, const float* __restrict__ be, bool fin) {
  float* X = (float*)(P.ws + WS_X); bf16_t* XB = (bf16_t*)(P.ws + WS_XB); float* STATS = (float*)(P.ws + WS_STATS);
  const int tid = ltid(), lane = tid & 63, w = tid >> 6;
  f32x4 gv[4], bv[4];
#pragma unroll
  for (int i = 0; i < 4; ++i) { gv[i] = *(const f32x4*)(g + 4 * (i * 64 + lane)); bv[i] = *(const f32x4*)(be + 4 * (i * 64 + lane)); }
  const int GW = gridDim.x * 8;
  for (int row0 = blockIdx.x * 8 + w; row0 < M_ALL; row0 += 2 * GW) {
    f32x4 v[2][4];
#pragma unroll
    for (int k = 0; k < 2; ++k) { const int row = min(row0 + k * GW, M_ALL - 1);
#pragma unroll
      for (int i = 0; i < 4; ++i) v[k][i] = *(const f32x4*)(X + (size_t)row * D + 4 * (i * 64 + lane)); }
#pragma unroll
    for (int k = 0; k < 2; ++k) {
      const int row = row0 + k * GW; if (row >= M_ALL) break;
      float s = 0.f;
#pragma unroll
      for (int i = 0; i < 4; ++i) s += v[k][i][0] + v[k][i][1] + v[k][i][2] + v[k][i][3];
      const float mu = wave_sum(s) * (1.f / D); float q = 0.f;
#pragma unroll
      for (int i = 0; i < 4; ++i) { v[k][i] -= mu; q += v[k][i][0] * v[k][i][0] + v[k][i][1] * v[k][i][1] + v[k][i][2] * v[k][i][2] + v[k][i][3] * v[k][i][3]; }
      const float rstd = rsqrtf(wave_sum(q) * (1.f / D) + LN_EPS);
      float* yo = nullptr;
      if (fin) { if (row >= M_P) yo = P.out + O_YS + (size_t)(row - M_P) * D; else { const int b = row / LP, t = row - b * LP; if (t >= NMETA) yo = P.out + O_YP + ((size_t)b * SEQ + (t - NMETA)) * D; } }
#pragma unroll
      for (int i = 0; i < 4; ++i) { const f32x4 y = v[k][i] * rstd * gv[i] + bv[i]; const int c = 4 * (i * 64 + lane);
        if (!fin) { u32x2 pk = {pk2(y[0], y[1]), pk2(y[2], y[3])}; *(u32x2*)(XB + (size_t)row * D + c) = pk; } if (yo) *(f32x4*)(yo + c) = y; }
      if (!fin && lane == 0) { f32x2 st = {mu, rstd}; *(f32x2*)(STATS + 2 * (size_t)row) = st; }
    }
  }
}
DI float gelu_tanh(float x) { const float y = 0.7978845608028654f * (x + 0.044715f * x * x * x); return x * __builtin_amdgcn_rcpf(1.f + __expf(-2.f * y)); }
DI void conv_phase(const Params& P, int l) {
  const bf16_t* __restrict__ G = (const bf16_t*)(P.ws + R_G); const bf16_t* __restrict__ U = (const bf16_t*)(P.ws + R_U); bf16_t* __restrict__ H = (bf16_t*)(P.ws + R_H);
  const float* __restrict__ cw = P.in[I_CW] + (size_t)l * 3 * DFF; const float* __restrict__ cb = P.in[I_CB] + (size_t)l * DFF; const float* __restrict__ st = P.in[I_CONV] + (size_t)l * DB * 2 * DFF;
  constexpr int NCH = DFF / 8;
  const int nth = gridDim.x * 512, gt = blockIdx.x * 512 + ltid(), nrg = nth / NCH, rpg = (M_ALL + nrg - 1) / nrg;
  const int ch = gt % NCH, rg = gt / NCH, f0 = 8 * ch;
  const int rb = rg * rpg, re = min(rb + rpg, M_ALL);
  if (rg < nrg && rb < re) {
    float w0[8], w1[8], w2[8], bb[8];
#pragma unroll
    for (int e = 0; e < 8; ++e) { w0[e] = cw[f0 + e]; w1[e] = cw[DFF + f0 + e]; w2[e] = cw[2 * DFF + f0 + e]; bb[e] = cb[f0 + e]; }
    float p1[8], p2[8];
    { const bf16x8 a = *(const bf16x8*)(G + (size_t)max(rb - 1, 0) * DFF + f0), c = *(const bf16x8*)(G + (size_t)max(rb - 2, 0) * DFF + f0);
#pragma unroll
      for (int e = 0; e < 8; ++e) { p1[e] = bf2f((unsigned short)a[e]); p2[e] = bf2f((unsigned short)c[e]); } }
    for (int r0 = rb; r0 < re; r0 += 4) {
      bf16x8 gq[4], uq[4];
#pragma unroll
      for (int k = 0; k < 4; ++k) { const int r = min(r0 + k, re - 1); gq[k] = *(const bf16x8*)(G + (size_t)r * DFF + f0); uq[k] = *(const bf16x8*)(U + (size_t)r * DFF + f0); }
#pragma unroll
      for (int k = 0; k < 4; ++k) {
        const int r = r0 + k; if (r >= re) break;
        const bool samp = r >= M_P; const int sb = samp ? (r - M_P) >> 4 : 0; const int t = samp ? ((r - M_P) & 15) : r % LP;
        if (t < 2) {
#pragma unroll
          for (int e = 0; e < 8; ++e) { if (t == 0) p1[e] = samp ? st[((size_t)sb * 2 + 1) * DFF + f0 + e] : 0.f; p2[e] = samp ? st[((size_t)sb * 2 + t) * DFF + f0 + e] : 0.f; }
        }
        float hv[8], gc[8];
#pragma unroll
        for (int e = 0; e < 8; ++e) { gc[e] = bf2f((unsigned short)gq[k][e]); const float x = bb[e] + w0[e] * p2[e] + w1[e] * p1[e] + w2[e] * gc[e];
          hv[e] = gelu_tanh(x) * bf2f((unsigned short)uq[k][e]); p2[e] = p1[e]; p1[e] = gc[e]; }
        *(bf16x8*)(H + (size_t)r * DFF + f0) = pk8(hv[0], hv[1], hv[2], hv[3], hv[4], hv[5], hv[6], hv[7]);
      }
    }
  }
}
DI void idx_load(bf16x8 (&kf)[4], const bf16_t* kp) {
#pragma unroll
  for (int s = 0; s < 4; ++s) kf[s] = *(const bf16x8*)(kp + 16 * s);
}
DI void idx_chain(f32x16& acc, const bf16x8 (&kf)[4], const bf16x8 (&q)[4]) {
#pragma unroll
  for (int r = 0; r < 16; ++r) acc[r] = 0.f;
#pragma unroll
  for (int s = 0; s < 4; ++s) acc = MFMA32(kf[s], q[s], acc);
}
DI void idx_lds4(bf16x8 (&q)[4], const unsigned char* qlds, int hd) {
#pragma unroll
  for (int s = 0; s < 4; ++s) q[s] = *(const bf16x8*)(qlds + ((hd - 1) * 4 + s) * 1024);
}
DI void idx_absfma(f32x16& sc, const f32x16& acc, float hw) {
  { float a = sc[0]; asm volatile("s_nop 7\n\ts_nop 3\n\tv_fma_f32 %0, |%1|, %2, %0" : "+v"(a) : "v"(acc[0]), "v"(hw)); sc[0] = a; }
#pragma unroll
  for (int r = 1; r < 16; ++r) { float a = sc[r]; asm volatile("v_fma_f32 %0, |%1|, %2, %0" : "+v"(a) : "v"(acc[r]), "v"(hw)); sc[r] = a; }
}
#define SB0 __builtin_amdgcn_sched_barrier(0)
DI void idx_scores(f32x16& sc, const bf16x8 (&q0)[4], const bf16x8 (&qlin)[4], const unsigned char* qlds  , const float (&hw)[8], const bf16x8 (&kf)[4]) {
  f32x16 a, b; bf16x8 qa[4], qb[4];
  idx_chain(sc, kf, qlin); idx_chain(a, kf, q0); idx_lds4(qa, qlds, 1); idx_lds4(qb, qlds, 2); SB0;
  idx_chain(b, kf, qa); SB0; idx_absfma(sc, a, hw[0]); idx_lds4(qa, qlds, 3); SB0;
  idx_chain(a, kf, qb); SB0; idx_absfma(sc, b, hw[1]); idx_lds4(qb, qlds, 4); SB0;
  idx_chain(b, kf, qa); SB0; idx_absfma(sc, a, hw[2]); idx_lds4(qa, qlds, 5); SB0;
  idx_chain(a, kf, qb); SB0; idx_absfma(sc, b, hw[3]); idx_lds4(qb, qlds, 6); SB0;
  idx_chain(b, kf, qa); SB0; idx_absfma(sc, a, hw[4]); idx_lds4(qa, qlds, 7); SB0;
  idx_chain(a, kf, qb); SB0; idx_absfma(sc, b, hw[5]); SB0;
  idx_chain(b, kf, qa); SB0; idx_absfma(sc, a, hw[6]); SB0;
  idx_absfma(sc, b, hw[7]);
}
DI unsigned ord_key(float f) { const unsigned u = __float_as_uint(f); return (u & 0x80000000u) ? ~u : (u | 0x80000000u); }
constexpr int HROW = 1025;
constexpr int HIST_BYTES = 32 * HROW * 4 + 64;
DI void indexer_item(const Params& P, unsigned char* lds, int e, int g) {
  const Entry E = get_entry(e);
  const int tid = ltid(), w = tid >> 6, lane = tid & 63, n = lane & 31, h = lane >> 5;
  const int tq = 32 * g + n; const bool qvalid = tq < E.Tq; const int tqc = qvalid ? tq : E.Tq - 1;
  const int vend = qvalid ? vis_end(E.samp, tqc) : 0;
  const int tq_last = min(32 * g + 31, E.Tq - 1); const int vmax = vis_end(E.samp, tq_last); const int nblk = (vmax + 31) >> 5;
  const bf16_t* QIB = (const bf16_t*)(P.ws + R_QIB); const bf16_t* KIB = (const bf16_t*)(P.ws + R_KIB); const float* WIB = (const float*)(P.ws + R_WIB);
  unsigned short* MASK = (unsigned short*)(P.ws + R_MASK);
  bf16x8 q0[4];
  unsigned char* qlds_base = lds + HIST_BYTES + 256;
  { const bf16_t* qip = QIB + (size_t)(E.qrow0 + tqc) * 512 + 8 * h;
#pragma unroll
    for (int s = 0; s < 4; ++s) q0[s] = *(const bf16x8*)(qip + 16 * s);
#pragma unroll
    for (int i = 0; i < 4; ++i) { const int f = w + 8 * i;
      if (f < 28) *(bf16x8*)(qlds_base + f * 1024 + lane * 16) = *(const bf16x8*)(qip + ((f >> 2) + 1) * 64 + 16 * (f & 3)); } }
  const unsigned char* qlds = qlds_base + lane * 16;
  __syncthreads();
  float wi[8];
  { const f32x4 a = *(const f32x4*)(WIB + (size_t)(E.qrow0 + tqc) * 8), b = *(const f32x4*)(WIB + (size_t)(E.qrow0 + tqc) * 8 + 4);
    wi[0] = 0.5f * a[0]; wi[1] = 0.5f * a[1]; wi[2] = 0.5f * a[2]; wi[3] = 0.5f * a[3]; wi[4] = 0.5f * b[0]; wi[5] = 0.5f * b[1]; wi[6] = 0.5f * b[2]; wi[7] = 0.5f * b[3]; }
  bf16x8 qlin[4];
  { const bf16_t* qip = QIB + (size_t)(E.qrow0 + tqc) * 512 + 8 * h;
#pragma unroll
    for (int s = 0; s < 4; ++s) { float acc8[8];
#pragma unroll
      for (int k = 0; k < 8; ++k) acc8[k] = 0.f;
#pragma unroll
      for (int hd = 0; hd < 8; ++hd) { const bf16x8 v = *(const bf16x8*)(qip + hd * 64 + 16 * s);
#pragma unroll
        for (int k = 0; k < 8; ++k) acc8[k] += wi[hd] * bf2f((unsigned short)v[k]); }
      qlin[s] = pk8(acc8[0], acc8[1], acc8[2], acc8[3], acc8[4], acc8[5], acc8[6], acc8[7]); } }
  unsigned* hist = (unsigned*)lds; unsigned* pref = (unsigned*)(lds + HIST_BYTES); unsigned* krem = pref + 32;
  constexpr int CAP = 448;
  u32x2* clist = (u32x2*)lds; unsigned* selh = (unsigned*)(lds + 32 * CAP * 8);
  unsigned* ccnt = (unsigned*)(lds + HIST_BYTES + 256 + 28672); unsigned* selres = ccnt + 32;
  const bf16_t* kbase = KIB + (size_t)(E.krow0 + pi_row(n)) * IDXD + 8 * h;
  const bool selall = vend <= TOPK;
  const bool havehist = vmax > TOPK;
  if (havehist && tid < 32) { pref[tid] = 0u; krem[tid] = TOPK; }
  for (int p = 0;; ++p) {
    if (havehist) {
      const unsigned shift = p == 0 ? 21u : (p == 1 ? 10u : 0u), nbits = p == 2 ? 10u : 11u;
      const unsigned pshift = p == 0 ? 0u : (p == 1 ? 21u : 10u), pwidth = p == 0 ? 0u : 32u - pshift;
      for (int i = tid; i < HIST_BYTES / 16; i += 512) ((u32x4*)hist)[i] = (u32x4){0u, 0u, 0u, 0u};
      __syncthreads();
      const unsigned mypref = pref[n];
      const unsigned hrow_b = (unsigned)n * (HROW * 4);
      for (int blk = w; blk < nblk; blk += 8) {
        bf16x8 kf[4]; idx_load(kf, kbase + (size_t)blk * 32 * IDXD);
        f32x16 sc; idx_scores(sc, q0, qlin, qlds, wi, kf);
        const int lim = vend - (32 * blk + 16 * h);
#pragma unroll
        for (int r = 0; r < 16; ++r) {
          const unsigned u = __float_as_uint(sc[r]); const unsigned ok = u ^ ((unsigned)((int)u >> 31) | 0x80000000u);
          const unsigned d = __builtin_amdgcn_ubfe(ok, shift, nbits);
          const bool match = (r < lim) & (__builtin_amdgcn_ubfe(ok, pshift, pwidth) == mypref);
          const unsigned val = match ? (d & 1u) * 0xffffu + 1u : 0u;
          const unsigned addr = hrow_b + ((d << 1) & 0xffcu);
          __hip_atomic_fetch_add((unsigned*)(lds + addr), val, __ATOMIC_RELAXED, __HIP_MEMORY_SCOPE_WORKGROUP);
        }
      }
      __syncthreads();
      { const int q = tid >> 4, j = tid & 15, seg = 15 - j; const unsigned* hq = hist + q * HROW + seg * 64; const int rot = 4 * j;
        unsigned s = 0;
#pragma unroll 8
        for (int i = 0; i < 64; ++i) { const unsigned x = hq[(i + rot) & 63]; s += (x & 0xffffu) + (x >> 16); }
        unsigned incl = s;
#pragma unroll
        for (int off = 1; off < 16; off <<= 1) { const unsigned t = __shfl_up(incl, off, 16); if (j >= off) incl += t; }
        const unsigned above = incl - s, kr = krem[q], pold = pref[q];
        if (above < kr && kr <= above + s) {
          unsigned c = above; int bin = 0; unsigned newk = 1;
#pragma unroll 1
          for (int i = 63; i >= 0; --i) { const unsigned x = hq[i], hi = x >> 16, lo = x & 0xffffu;
            if (c + hi >= kr) { bin = 128 * seg + 2 * i + 1; newk = kr - c; break; } c += hi;
            if (c + lo >= kr) { bin = 128 * seg + 2 * i; newk = kr - c; break; } c += lo; }
          pref[q] = p == 0 ? (unsigned)bin : ((pold << (p == 1 ? 11 : 10)) | (unsigned)bin); krem[q] = newk;
        }
      }
      if (tid < 32) ccnt[tid] = 0u;
      __syncthreads();
    }
    const unsigned psh = (havehist && p < 2 && !selall) ? (p == 0 ? 21u : 10u) : 0u;
    const unsigned pl = (havehist && !selall) ? pref[n] : 0u;
    for (int blk = w; blk < nblk; blk += 8) {
      bf16x8 kf[4]; idx_load(kf, kbase + (size_t)blk * 32 * IDXD);
      f32x16 sc; idx_scores(sc, q0, qlin, qlds, wi, kf);
      const int lim = vend - (32 * blk + 16 * h);
      unsigned bits = 0u;
#pragma unroll
      for (int r = 0; r < 16; ++r) {
        const unsigned okp = ord_key(sc[r]) >> psh; const bool vis = r < lim;
        if (vis && (okp > pl || (okp == pl && psh == 0u))) bits |= 1u << r;
        if (vis && okp == pl && psh != 0u) {
          const unsigned slot = __hip_atomic_fetch_add(&ccnt[n], 1u, __ATOMIC_RELAXED, __HIP_MEMORY_SCOPE_WORKGROUP);
          if (slot < (unsigned)CAP) { u32x2 ent = {ord_key(sc[r]), (unsigned)(32 * blk + 16 * h + r)}; clist[n * CAP + slot] = ent; }
        }
      }
      if (qvalid) MASK[E.mask_off + ((size_t)blk * E.Tq + tq) * 2 + h] = (unsigned short)bits;
    }
    if (!havehist || p == 2) break;
    asm volatile("s_waitcnt vmcnt(0)" ::: "memory");
    __syncthreads();
    unsigned ovf = 0u;
#pragma unroll
    for (int i = 0; i < 32; i += 4) { const u32x4 c4 = *(const u32x4*)(ccnt + i); ovf |= (c4[0] > (unsigned)CAP) | (c4[1] > (unsigned)CAP) | (c4[2] > (unsigned)CAP) | (c4[3] > (unsigned)CAP); }
    if (ovf) continue;
    { const int q = tid >> 4, j = tid & 15, tqq = 32 * g + q;
      const bool active = tqq < E.Tq && vis_end(E.samp, min(tqq, E.Tq - 1)) > TOPK;
      const unsigned cnt = active ? ccnt[q] : 0u; unsigned need = krem[q];
      const int rem0 = p == 0 ? 21 : 10; const unsigned lowmask = (1u << rem0) - 1u;
      const u32x2* cl = clist + q * CAP; unsigned* sh = selh + q * 128; unsigned* MASK32 = (unsigned*)(P.ws + R_MASK) + (E.mask_off >> 1);
      unsigned selp = 0u, eqc = 0u;
      for (int rem = rem0; rem > 0;) {
        const int wd = rem < 7 ? rem : 7, shf = rem - wd;
#pragma unroll
        for (int i = 0; i < 8; ++i) sh[j * 8 + i] = 0u;
        __syncthreads();
#pragma unroll 1
        for (unsigned i = j; i < cnt; i += 16) { const unsigned low = cl[i][0] & lowmask; if ((low >> rem) == selp) __hip_atomic_fetch_add(&sh[(low >> shf) & ((1u << wd) - 1u)], 1u, __ATOMIC_RELAXED, __HIP_MEMORY_SCOPE_WORKGROUP); }
        __syncthreads();
        { const int seg = 15 - j; unsigned sseg = 0;
#pragma unroll
          for (int i = 0; i < 8; ++i) sseg += sh[8 * seg + i];
          unsigned incl = sseg;
#pragma unroll
          for (int off = 1; off < 16; off <<= 1) { const unsigned t = __shfl_up(incl, off, 16); if (j >= off) incl += t; }
          const unsigned above = incl - sseg;
          if (active && above < need && need <= above + sseg) {
            unsigned c = above;
            for (int i = 7; i >= 0; --i) { const unsigned x = sh[8 * seg + i]; if (c + x >= need) { selres[q * 3] = (unsigned)(8 * seg + i); selres[q * 3 + 1] = need - c; selres[q * 3 + 2] = x; break; } c += x; }
          }
        }
        __syncthreads();
        selp = (selp << wd) | selres[q * 3]; need = selres[q * 3 + 1]; eqc = selres[q * 3 + 2];
        rem = shf;
      }
#pragma unroll 1
      for (unsigned i = j; i < cnt; i += 16) {
        const u32x2 ent = cl[i]; const unsigned low = ent[0] & lowmask; bool take = low > selp;
        if (low == selp) {
          if (need >= eqc) take = true;
          else { unsigned rank = 0; for (unsigned k = 0; k < cnt; ++k) { const u32x2 o2 = cl[k]; rank += ((o2[0] & lowmask) == selp && o2[1] < ent[1]) ? 1u : 0u; } take = rank < need; }
        }
        if (take) atomicOr(MASK32 + (size_t)(ent[1] >> 5) * E.Tq + tqq, 1u << (ent[1] & 31u));
      }
    }
    break;
  }
  __syncthreads();
}
DI void indexer_phase(const Params& P, unsigned char* lds, int cidx) {
  constexpr int NIT = NB * 257 + DB;
  unsigned* ctr = (unsigned*)(P.ws + WS_BAR + 14336) + cidx;
  for (;;) {
    const int it = next_item(ctr, lds); if (it >= NIT) break;
    const bool pr = it < NB * 257; indexer_item(P, lds, pr ? (it & 3) : NB + (it - NB * 257), pr ? 256 - (it >> 2) : 0);
  }
}
constexpr int KT_K = 64 * 272 + 512, KT_V = 128 * 144, KT_STAGE = KT_K + KT_V;
DI void dsa_attn_item(const Params& P, unsigned char* lds, int e, int head, int qt) {
  const Entry E = get_entry(e);
  const int tid = ltid(), w = tid >> 6, lane = tid & 63, n = lane & 31, h = lane >> 5;
  const int wq0 = qt * 256 + w * 32, tq = wq0 + n; const bool qvalid = tq < E.Tq; const int tqc = qvalid ? tq : E.Tq - 1;
  const int qpos = E.qpos0 + tqc;
  const int nkt = (vis_end(E.samp, min(qt * 256 + 255, E.Tq - 1)) + 63) >> 6;
  const int wvmax = wq0 < E.Tq ? vis_end(E.samp, min(wq0 + 31, E.Tq - 1)) : 0;
  const bf16_t* QB = (const bf16_t*)(P.ws + R_QB); const bf16_t* KB = (const bf16_t*)(P.ws + R_KB);
  const bf16_t* VTb = (const bf16_t*)(P.ws + (E.samp ? R_VTS : R_VT)) + E.vt_off + (size_t)head * HDIM * E.pitch;
  const unsigned short* MASK = (const unsigned short*)(P.ws + R_MASK) + E.mask_off + (size_t)tqc * 2 + h;
  bf16_t* OB = (bf16_t*)(P.ws + R_OB);
  float* biasl = (float*)(lds + 2 * KT_STAGE);
  if (tid < 257) biasl[tid] = P.in[I_RELB][rel_bucket(tid - 128) * NH + head] * LOG2E;
  const float bias_far = P.in[I_RELB][15 * NH + head] * LOG2E;
  bf16x8 qf[8];
  { const bf16_t* qp = QB + (size_t)(E.qrow0 + tqc) * D + head * HDIM + 8 * h;
#pragma unroll
    for (int s = 0; s < 8; ++s) qf[s] = *(const bf16x8*)(qp + 16 * s); }
  f32x16 o[4];
#pragma unroll
  for (int db = 0; db < 4; ++db)
#pragma unroll
    for (int r = 0; r < 16; ++r) o[db][r] = 0.f;
  float m = -1e30f, lsum = 0.f;
  const bf16_t* gK[2]; const bf16_t* gV[2]; int lK[2], lV[2];
#pragma unroll
  for (int i = 0; i < 2; ++i) { const int c = tid + 512 * i;
    gK[i] = KB + (size_t)(E.krow0 + (c >> 4)) * D + head * HDIM + (c & 15) * 8; lK[i] = (c >> 4) * 272 + (c >> 8) * 128 + (c & 15) * 16;
    gV[i] = VTb + (size_t)(c >> 3) * E.pitch + (c & 7) * 8; lV[i] = KT_K + (c >> 3) * 144 + (c & 7) * 16; }
  bf16x8 rk[2], rv[2];
#pragma unroll
  for (int i = 0; i < 2; ++i) { rk[i] = *(const bf16x8*)gK[i]; rv[i] = *(const bf16x8*)gV[i]; }
#pragma unroll
  for (int i = 0; i < 2; ++i) { *(bf16x8*)(lds + lK[i]) = rk[i]; *(bf16x8*)(lds + lV[i]) = rv[i]; }
  __syncthreads();
  unsigned pb0 = 0u, pb1 = 0u;
  if (qvalid && 0 < wvmax) { pb0 = MASK[0]; if (32 < wvmax) pb1 = MASK[(size_t)E.Tq * 2]; }
  const int arow = pi_row(n) * 272 + (pi_row(n) >> 4) * 128 + 16 * h;
  const int vrow = n * 144 + 32 * h;
  for (int kt = 0; kt < nkt; ++kt) {
    const int buf = kt & 1; const bool more = kt + 1 < nkt;
    const unsigned nbits0 = pb0, nbits1 = pb1;
    if (more) {
#pragma unroll
      for (int i = 0; i < 2; ++i) { rk[i] = *(const bf16x8*)(gK[i] + (size_t)(kt + 1) * 64 * D); rv[i] = *(const bf16x8*)(gV[i] + (kt + 1) * 64); }
      pb0 = 0u; pb1 = 0u;
      if (qvalid && 64 * (kt + 1) < wvmax) { pb0 = MASK[(size_t)(2 * kt + 2) * E.Tq * 2]; if (64 * (kt + 1) + 32 < wvmax) pb1 = MASK[(size_t)(2 * kt + 3) * E.Tq * 2]; }
    }
    if (64 * kt < wvmax) {
      const unsigned char* sK = lds + buf * KT_STAGE; const unsigned char* sV = sK + KT_K;
      const bool far_t = 64 * kt + 63 - (E.qpos0 + wq0) <= -91;
      const float binit = far_t ? bias_far : 0.f;
      f32x16 s0, s1;
#pragma unroll
      for (int r = 0; r < 16; ++r) { s0[r] = binit; s1[r] = binit; }
#pragma unroll
      for (int s = 0; s < 8; ++s) {
        const bf16x8 k0 = *(const bf16x8*)(sK + arow + 32 * s), k1 = *(const bf16x8*)(sK + 32 * 272 + 256 + arow + 32 * s);
        s0 = MFMA32(k0, qf[s], s0); s1 = MFMA32(k1, qf[s], s1);
      }
      const unsigned bits0 = nbits0, bits1 = nbits1;
      if (!far_t) {
        const int rel0 = 64 * kt + 16 * h - qpos;
#pragma unroll
        for (int r = 0; r < 16; ++r) {
          const int i0 = min(max(rel0 + r, -128), 128) + 128, i1 = min(max(rel0 + r + 32, -128), 128) + 128;
          s0[r] += biasl[i0]; s1[r] += biasl[i1];
        }
      }
      float mx = -1e30f;
#pragma unroll
      for (int r = 0; r < 16; ++r) {
        const unsigned t0 = (unsigned)__builtin_amdgcn_sbfe((int)bits0, r, 1), t1 = (unsigned)__builtin_amdgcn_sbfe((int)bits1, r, 1);
        s0[r] = __uint_as_float((__float_as_uint(s0[r]) & t0) | (~t0 & 0xff800000u)); s1[r] = __uint_as_float((__float_as_uint(s1[r]) & t1) | (~t1 & 0xff800000u));
        mx = fmaxf(mx, fmaxf(s0[r], s1[r]));
      }
      mx = fmaxf(mx, __shfl_xor(mx, 32));
      const float mn = fmaxf(m, mx);
      if (__any(mn > m)) {
        const float scale = __builtin_amdgcn_exp2f(m - mn); lsum *= scale;
#pragma unroll
        for (int db = 0; db < 4; ++db)
#pragma unroll
          for (int r = 0; r < 16; ++r) o[db][r] *= scale;
      }
      m = mn;
      float ps = 0.f;
#pragma unroll
      for (int r = 0; r < 16; ++r) { s0[r] = __builtin_amdgcn_exp2f(s0[r] - mn); s1[r] = __builtin_amdgcn_exp2f(s1[r] - mn); ps += s0[r] + s1[r]; }
      lsum += ps;
#pragma unroll
      for (int s2 = 0; s2 < 2; ++s2) {
        const bf16x8 p0 = pk8(s0[8 * s2], s0[8 * s2 + 1], s0[8 * s2 + 2], s0[8 * s2 + 3], s0[8 * s2 + 4], s0[8 * s2 + 5], s0[8 * s2 + 6], s0[8 * s2 + 7]);
        const bf16x8 p1 = pk8(s1[8 * s2], s1[8 * s2 + 1], s1[8 * s2 + 2], s1[8 * s2 + 3], s1[8 * s2 + 4], s1[8 * s2 + 5], s1[8 * s2 + 6], s1[8 * s2 + 7]);
#pragma unroll
        for (int db = 0; db < 4; ++db) {
          const bf16x8 v0 = *(const bf16x8*)(sV + db * 32 * 144 + vrow + 16 * s2), v1 = *(const bf16x8*)(sV + db * 32 * 144 + vrow + 64 + 16 * s2);
          o[db] = MFMA32(v0, p0, o[db]); o[db] = MFMA32(v1, p1, o[db]);
        }
      }
    }
    if (more) {
      unsigned char* nb = lds + (buf ^ 1) * KT_STAGE;
#pragma unroll
      for (int i = 0; i < 2; ++i) { *(bf16x8*)(nb + lK[i]) = rk[i]; *(bf16x8*)(nb + lV[i]) = rv[i]; }
    }
    __syncthreads();
  }
  lsum += __shfl_xor(lsum, 32);
  if (qvalid) {
    const float inv = 1.f / lsum; bf16_t* op = OB + (size_t)(E.qrow0 + tq) * D + head * HDIM + 4 * h;
#pragma unroll
    for (int db = 0; db < 4; ++db)
#pragma unroll
      for (int g4 = 0; g4 < 4; ++g4) { u32x2 pk = {pk2(o[db][4 * g4] * inv, o[db][4 * g4 + 1] * inv), pk2(o[db][4 * g4 + 2] * inv, o[db][4 * g4 + 3] * inv)};
        *(u32x2*)(op + 32 * db + 8 * g4) = pk; }
  }
}
DI void dsa_attn_phase(const Params& P, unsigned char* lds, int cidx) {
  constexpr int NPI = NB * NH * 33, NIT = NPI + DB * NH;
  unsigned* ctr = (unsigned*)(P.ws + WS_BAR + 14336) + cidx;
  for (;;) {
    const int it = next_item(ctr, lds); if (it >= NIT) break;
    const bool pr = it < NPI; const int s = it - NPI; dsa_attn_item(P, lds, pr ? (it & 3) : NB + (s >> 3), pr ? ((it >> 2) & 7) : (s & 7), pr ? 32 - (it >> 5) : 0);
  }
}
DI void sb_item(const Params& P, int e, int head, int g, int lane) {
  const Entry E = get_entry(e);
  const int n = lane & 31, h = lane >> 5;
  const int tq = 32 * g + n; const bool qvalid = tq < E.Tq; const int tqc = qvalid ? tq : E.Tq - 1; const int qpos = E.qpos0 + tqc;
  const bf16_t* QB = (const bf16_t*)(P.ws + R_QB); const bf16_t* KB = (const bf16_t*)(P.ws + R_KB);
  const bf16_t* VTb = (const bf16_t*)(P.ws + (E.samp ? R_VTS : R_VT)) + E.vt_off + (size_t)head * HDIM * E.pitch;
  bf16_t* OB = (bf16_t*)(P.ws + R_OB);
  bf16x8 qf[8];
  { const bf16_t* qp = QB + (size_t)(E.qrow0 + tqc) * D + head * HDIM + 8 * h;
#pragma unroll
    for (int s = 0; s < 8; ++s) qf[s] = *(const bf16x8*)(qp + 16 * s); }
  f32x16 o[4];
#pragma unroll
  for (int db = 0; db < 4; ++db)
#pragma unroll
    for (int r = 0; r < 16; ++r) o[db][r] = 0.f;
  float carry = 0.f;
  const bf16_t* kp0 = KB + (size_t)(E.krow0 + pi_row(n)) * D + head * HDIM + 8 * h;
  const bf16_t* vp0 = VTb + (size_t)n * E.pitch + 16 * h;
  const int kb0 = (E.qpos0 + 32 * g) >> 5;
  bf16x8 kfn[8], vfn[4][2];
#pragma unroll
  for (int s = 0; s < 8; ++s) kfn[s] = *(const bf16x8*)(kp0 + (size_t)kb0 * 32 * D + 16 * s);
#pragma unroll
  for (int db = 0; db < 4; ++db)
#pragma unroll
    for (int s2 = 0; s2 < 2; ++s2) vfn[db][s2] = *(const bf16x8*)(vp0 + (size_t)db * 32 * E.pitch + kb0 * 32 + 8 * s2);
  for (int kb = kb0; kb >= 0; --kb) {
    bf16x8 kf[8], vf[4][2];
#pragma unroll
    for (int s = 0; s < 8; ++s) kf[s] = kfn[s];
#pragma unroll
    for (int db = 0; db < 4; ++db)
#pragma unroll
      for (int s2 = 0; s2 < 2; ++s2) vf[db][s2] = vfn[db][s2];
    { const int kn = kb > 0 ? kb - 1 : 0;
#pragma unroll
      for (int s = 0; s < 8; ++s) kfn[s] = *(const bf16x8*)(kp0 + (size_t)kn * 32 * D + 16 * s);
#pragma unroll
      for (int db = 0; db < 4; ++db)
#pragma unroll
        for (int s2 = 0; s2 < 2; ++s2) vfn[db][s2] = *(const bf16x8*)(vp0 + (size_t)db * 32 * E.pitch + kn * 32 + 8 * s2); }
    f32x16 z;
#pragma unroll
    for (int r = 0; r < 16; ++r) z[r] = 0.f;
#pragma unroll
    for (int s = 0; s < 8; ++s) z = MFMA32(kf[s], qf[s], z);
    float ls[16], bt[16]; float run = 0.f;
#pragma unroll
    for (int r = 15; r >= 0; --r) {
      const int kpos = 32 * kb + 16 * h + r; const bool causal = qvalid && kpos < qpos;
      const float zz = z[r], sp = fmaxf(zz, 0.f) + __logf(1.f + __expf(-fabsf(zz)));
      ls[r] = causal ? zz - sp : -1e30f;
      bt[r] = run; run += causal ? -sp : 0.f;
    }
    const float other = __shfl_xor(run, 32);
    const float base = carry + (h == 0 ? other : 0.f);
    float a[16];
#pragma unroll
    for (int r = 0; r < 16; ++r) a[r] = ls[r] > -1e29f ? __expf(ls[r] + base + bt[r]) : 0.f;
    carry += run + other;
#pragma unroll
    for (int s2 = 0; s2 < 2; ++s2) {
      const bf16x8 pf = pk8(a[8 * s2], a[8 * s2 + 1], a[8 * s2 + 2], a[8 * s2 + 3], a[8 * s2 + 4], a[8 * s2 + 5], a[8 * s2 + 6], a[8 * s2 + 7]);
#pragma unroll
      for (int db = 0; db < 4; ++db) o[db] = MFMA32(vf[db][s2], pf, o[db]);
    }
    const bool done = !qvalid || carry < -30.f;
    if (__all(done)) break;
  }
  if (qvalid) {
    bf16_t* op = OB + (size_t)(E.qrow0 + tq) * D + head * HDIM + 4 * h;
#pragma unroll
    for (int db = 0; db < 4; ++db)
#pragma unroll
      for (int g4 = 0; g4 < 4; ++g4) { u32x2 pk = {pk2(o[db][4 * g4], o[db][4 * g4 + 1]), pk2(o[db][4 * g4 + 2], o[db][4 * g4 + 3])};
        *(u32x2*)(op + 32 * db + 8 * g4) = pk; }
  }
}
DI void sb_phase(const Params& P, int cidx) {
  constexpr int NPI = NB * NH * 257, NIT = NPI + DB * NH;
  const int lane = ltid() & 63;
  unsigned* ctr = (unsigned*)(P.ws + WS_BAR + 14336) + cidx;
  for (;;) {
    int it = 0; if (lane == 0) it = (int)__hip_atomic_fetch_add(ctr, 1u, __ATOMIC_RELAXED, __HIP_MEMORY_SCOPE_AGENT);
    it = __builtin_amdgcn_readfirstlane(it); if (it >= NIT) break;
    const bool pr = it < NPI; const int s = it - NPI; sb_item(P, pr ? (it & 3) : NB + (s >> 3), pr ? ((it >> 2) & 7) : (s & 7), pr ? 256 - (it >> 5) : 0, lane);
  }
}
__global__ void __launch_bounds__(512, 2) fwd_megakernel(Params P0) {
  extern __shared__ __attribute__((aligned(16))) unsigned char shm[];
  cg::grid_group grid = cg::this_grid();
  unsigned char* lds = shm;
  if (threadIdx.x < 2) ((unsigned*)(lds + LDS_PARAMS + 208))[threadIdx.x] = 0u;
  store_params(P0, lds);
  const XcdBarrier xb = xcd_barrier_post((unsigned*)(P0.ws + WS_BAR), (volatile LAS unsigned*)(lds + LDS_PARAMS + 208));
  { const Params P = load_params(lds); phase0(P, lds); }
  if (P0.ws == nullptr) grid.sync();
  xcd_barrier(xb);
#pragma unroll 1
  for (int l = 0; l < 4; ++l) {
    const bool isA = !(l & 1); const int j = l >> 1;
    { const Params P = load_params(lds); cache_phase(P, lds, isA, j); }
    __syncthreads();
    { const Params P = load_params(lds); EpiInProj E{isA ? 1 : 0, j, P.out, P.ws}; const bf16_t* XB = (const bf16_t*)(P.ws + WS_XB);
      if (isA) { const bf16_t* W = (const bf16_t*)(P.ws + W_AIN) + (size_t)j * A_IN_PAD * D; run_gemm(lds, XB, W, M_MAIN, A_IN_PAD, D, E); tail_gemm(lds, XB, W, A_IN, D, E, (unsigned*)(P.ws + WS_BAR + 14336) + 16 + 5 * l); }
      else { const bf16_t* W = (const bf16_t*)(P.ws + W_BIN) + (size_t)j * B_IN * D; run_gemm(lds, XB, W, M_MAIN, B_IN, D, E); tail_gemm(lds, XB, W, B_IN, D, E, (unsigned*)(P.ws + WS_BAR + 14336) + 16 + 5 * l); } }
    xcd_barrier(xb);
    if (isA) { { const Params P = load_params(lds); indexer_phase(P, lds, 4 * l); } xcd_barrier(xb); { const Params P = load_params(lds); dsa_attn_phase(P, lds, 4 * l + 1); } }
    else { const Params P = load_params(lds); sb_phase(P, 4 * l + 2); }
    xcd_barrier(xb);
    { const Params P = load_params(lds); EpiResid E{(float*)(P.ws + WS_X), (const float*)(P.ws + WS_STATS), P.in[I_LN2G] + (l > 0 ? l - 1 : 0) * D, P.in[I_LN2B] + (l > 0 ? l - 1 : 0) * D, l == 0 ? 1 : 0}; const bf16_t* W = (const bf16_t*)(P.ws + (isA ? W_AOUT : W_BOUT)) + (size_t)j * D * D; run_gemm(lds, (const bf16_t*)(P.ws + R_OB), W, M_MAIN, D, D, E); tail_gemm(lds, (const bf16_t*)(P.ws + R_OB), W, D, D, E, (unsigned*)(P.ws + WS_BAR + 14336) + 16 + 5 * l + 1); }
    xcd_barrier(xb);
    { const Params P = load_params(lds); ln_phase(P, P.in[I_LN1G] + l * D, P.in[I_LN1B] + l * D, false); }
    xcd_barrier(xb);
    { const Params P = load_params(lds); EpiFFN1 E{l, P.out, P.ws}; const bf16_t* W = (const bf16_t*)(P.ws + W_FFN1) + (size_t)l * 2 * DFF * D; run_gemm(lds, (const bf16_t*)(P.ws + WS_XB), W, M_MAIN, 2 * DFF, D, E); tail_gemm(lds, (const bf16_t*)(P.ws + WS_XB), W, 2 * DFF, D, E, (unsigned*)(P.ws + WS_BAR + 14336) + 16 + 5 * l + 2); }
    xcd_barrier(xb);
    { const Params P = load_params(lds); conv_phase(P, l); }
    xcd_barrier(xb);
    { const Params P = load_params(lds); EpiResid E{(float*)(P.ws + WS_X), (const float*)(P.ws + WS_STATS), P.in[I_LN1G] + l * D, P.in[I_LN1B] + l * D, 0}; const bf16_t* W = (const bf16_t*)(P.ws + W_FFN2) + (size_t)l * D * DFF; run_gemm(lds, (const bf16_t*)(P.ws + R_H), W, M_MAIN, D, DFF, E); tail_gemm(lds, (const bf16_t*)(P.ws + R_H), W, D, DFF, E, (unsigned*)(P.ws + WS_BAR + 14336) + 16 + 5 * l + 3); }
    xcd_barrier(xb);
    { const Params P = load_params(lds); ln_phase(P, P.in[I_LN2G] + l * D, P.in[I_LN2B] + l * D, l == 3); }
    if (l < 3) xcd_barrier(xb);
  }
}

extern "C" void kernel_launch(void* const* d_in, const int* in_sizes, int n_in, void* d_out, int out_size, void* d_ws, size_t ws_size, hipStream_t stream) {
  static int grid_blocks = 0;
  if (!grid_blocks) {
    int dev = 0, cus = 0, per_cu = 0;
    hipGetDevice(&dev);
    hipDeviceGetAttribute(&cus, hipDeviceAttributeMultiprocessorCount, dev);
    hipFuncSetAttribute((const void*)fwd_megakernel, hipFuncAttributeMaxDynamicSharedMemorySize, LDS_BYTES);
    hipOccupancyMaxActiveBlocksPerMultiprocessor(&per_cu, fwd_megakernel, 512, LDS_BYTES);
    if (per_cu < 1) per_cu = 1;
    if (per_cu > 1) per_cu = 1;
    grid_blocks = cus * per_cu;
  }
  Params p{};
  for (int i = 0; i < 23; ++i) p.in[i] = (const float*)d_in[i];
  p.out = (float*)d_out; p.ws = (unsigned char*)d_ws;
  if (ws_size < WS_NEED) { fprintf(stderr, "workspace too small: %zu < %zu\n", ws_size, (size_t)WS_NEED); }
  (void)hipMemsetAsync((unsigned char*)d_ws + WS_BAR, 0, 16384, stream);
  void* args[] = {&p};
  hipError_t err = hipLaunchCooperativeKernel((void*)fwd_megakernel, dim3(grid_blocks), dim3(512), args, LDS_BYTES, stream);
  if (err != hipSuccess) fprintf(stderr, "cooperative launch failed: %s (grid %d)\n", hipGetErrorString(err), grid_blocks);
}
```
